# Optimizing an MI355X kernel written in HIP

```python
import math
import jax, jax.numpy as jnp
from jax import lax
import numpy as np

D_MODEL = 2048
BATCH = 4
SEQ = 2048
DEPTH = 1

MEM_LEN = 256
DA_HEADS = 4
DA_HEAD_DIM = 128
DA_V_DIM = 2 * DA_HEAD_DIM
RET_HEADS = 4
RET_QK_DIM = 128
RET_V_DIM = 256
MIX_WIDTH = DA_HEADS * DA_V_DIM + RET_HEADS * RET_V_DIM
COL_SIZES = (
    DA_HEADS * 2 * DA_HEAD_DIM,
    DA_HEADS * 2 * DA_HEAD_DIM,
    DA_HEADS * DA_V_DIM,
    RET_HEADS * RET_QK_DIM,
    RET_HEADS * RET_QK_DIM,
    RET_HEADS * RET_V_DIM,
    RET_HEADS * RET_V_DIM,
)
IN_COLS = sum(COL_SIZES)
XATTN_HEADS = 4
XATTN_HEAD_DIM = D_MODEL // XATTN_HEADS
D_FF = ((8 * D_MODEL + 3 * 256 - 1) // (3 * 256)) * 256
BLOCK = 128
CHUNK = 128
NORM_EPS = 1e-6
NEG_INF = -1e30

kernel_name = "hybrid_diffattn_retention_block"


def rmsnorm(x, g=None, eps=NORM_EPS):
    x32 = x.astype(jnp.float32)
    y = x32 * lax.rsqrt(jnp.mean(x32 * x32, axis=-1, keepdims=True) + eps)
    if g is not None:
        y = y * g.astype(jnp.float32)
    return y.astype(x.dtype)


def alibi_slopes(n_heads):
    return jnp.asarray(2.0 ** (-8.0 * np.arange(1, n_heads + 1) / n_heads), dtype=jnp.float32)


def retention_log_gammas(n_heads):
    return jnp.asarray(np.log(1.0 - 2.0 ** (-5.0 - np.arange(n_heads))), dtype=jnp.float32)


def split_cols(p):
    out, start = [], 0
    for size in COL_SIZES:
        out.append(p[..., start:start + size])
        start += size
    return out


def diff_attention(q, k, v, lam, slopes):
    b, s, h, _, d = q.shape
    nb = s // BLOCK
    scale = d ** -0.5
    qb = q.reshape(b, nb, BLOCK, h, 2, d).transpose(1, 0, 2, 3, 4, 5)
    kpos = jnp.arange(s)
    lam32 = lam.astype(jnp.float32)

    def one_block(args):
        qi, i = args
        qpos = i * BLOCK + jnp.arange(BLOCK)
        sc = jnp.einsum('bqhcd,bkhcd->bhcqk', qi, k).astype(jnp.float32) * scale
        dist = (qpos[:, None] - kpos[None, :]).astype(jnp.float32)
        bias = -slopes[:, None, None, None] * dist
        sc = jnp.where(dist >= 0, sc + bias, NEG_INF)
        p = jax.nn.softmax(sc, axis=-1)
        a = p[:, :, 0] - lam32 * p[:, :, 1]
        return jnp.einsum('bhqk,bkhe->bqhe', a.astype(v.dtype), v)

    out = lax.map(one_block, (qb, jnp.arange(nb)))
    return out.transpose(1, 0, 2, 3, 4).reshape(b, s, h, v.shape[-1])


def retention(q, k, v, log_gamma):
    b, s, h, dk = q.shape
    dv = v.shape[-1]
    n = s // CHUNK
    f32 = jnp.float32
    qc = q.astype(f32).reshape(b, n, CHUNK, h, dk).transpose(1, 0, 2, 3, 4)
    kc = (k.astype(f32) * dk ** -0.5).reshape(b, n, CHUNK, h, dk).transpose(1, 0, 2, 3, 4)
    vc = v.astype(f32).reshape(b, n, CHUNK, h, dv).transpose(1, 0, 2, 3, 4)
    idx = jnp.arange(CHUNK, dtype=f32)
    diff = idx[:, None] - idx[None, :]
    intra = jnp.where(diff >= 0, jnp.exp(log_gamma[:, None, None] * jnp.maximum(diff, 0.0)), 0.0)
    q_decay = jnp.exp(log_gamma[None, :] * (idx[:, None] + 1.0))[None, :, :, None]
    k_decay = jnp.exp(log_gamma[None, :] * (CHUNK - 1.0 - idx[:, None]))[None, :, :, None]
    chunk_decay = jnp.exp(log_gamma * CHUNK)[None, :, None, None]

    def step(state, inp):
        qi, ki, vi = inp
        scores = jnp.einsum('bihd,bjhd->bhij', qi, ki) * intra
        inner = jnp.einsum('bhij,bjhe->bihe', scores, vi)
        cross = jnp.einsum('bihd,bhde->bihe', qi, state) * q_decay
        new_state = state * chunk_decay + jnp.einsum('bjhd,bjhe->bhde', ki * k_decay, vi)
        return new_state, inner + cross

    state0 = jnp.zeros((b, h, dk, dv), f32)
    _, out = lax.scan(step, state0, (qc, kc, vc))
    return out.transpose(1, 0, 2, 3, 4).reshape(b, s, h, dv).astype(q.dtype)


def setup_inputs(seed: int = 0) -> dict:
    key = jax.random.key(seed)
    ks = jax.random.split(key, 24)
    f32 = jnp.float32

    def w(k, shape, fan_in):
        return jax.random.normal(k, shape, f32) * fan_in ** -0.5

    def gain(k, shape):
        return 1.0 + 0.02 * jax.random.normal(k, shape, f32)

    return {
        "x": jax.random.normal(ks[0], (BATCH, SEQ, D_MODEL), f32),
        "mem": jax.random.normal(ks[1], (BATCH, MEM_LEN, D_MODEL), f32),
        "norm_mix_g": gain(ks[2], (DEPTH, D_MODEL)),
        "w_in": w(ks[3], (DEPTH, D_MODEL, IN_COLS), D_MODEL),
        "lambda_q1": 0.1 * jax.random.normal(ks[4], (DEPTH, DA_HEAD_DIM), f32),
        "lambda_k1": 0.1 * jax.random.normal(ks[5], (DEPTH, DA_HEAD_DIM), f32),
        "lambda_q2": 0.1 * jax.random.normal(ks[6], (DEPTH, DA_HEAD_DIM), f32),
        "lambda_k2": 0.1 * jax.random.normal(ks[7], (DEPTH, DA_HEAD_DIM), f32),
        "da_subln_g": gain(ks[8], (DEPTH, DA_V_DIM)),
        "w_o": w(ks[9], (DEPTH, MIX_WIDTH, D_MODEL), MIX_WIDTH),
        "norm_x_g": gain(ks[10], (DEPTH, D_MODEL)),
        "norm_mem_g": gain(ks[11], (DEPTH, D_MODEL)),
        "w_xq": w(ks[12], (DEPTH, D_MODEL, D_MODEL), D_MODEL),
        "w_xk": w(ks[13], (DEPTH, D_MODEL, D_MODEL), D_MODEL),
        "w_xv": w(ks[14], (DEPTH, D_MODEL, D_MODEL), D_MODEL),
        "w_xo": w(ks[15], (DEPTH, D_MODEL, D_MODEL), D_MODEL),
        "norm_ffn_g": gain(ks[16], (DEPTH, D_MODEL)),
        "w_gate": w(ks[17], (DEPTH, D_MODEL, D_FF), D_MODEL),
        "w_up": w(ks[18], (DEPTH, D_MODEL, D_FF), D_MODEL),
        "w_down": w(ks[19], (DEPTH, D_FF, D_MODEL), D_FF),
        "norm_f_g": gain(ks[20], (D_MODEL,)),
    }


def reference(x, mem, norm_mix_g, w_in, lambda_q1, lambda_k1, lambda_q2, lambda_k2,
              da_subln_g, w_o, norm_x_g, norm_mem_g, w_xq, w_xk, w_xv, w_xo,
              norm_ffn_g, w_gate, w_up, w_down, norm_f_g):
    b, s, _ = x.shape
    slopes = alibi_slopes(DA_HEADS)
    log_gamma = retention_log_gammas(RET_HEADS)
    for l in range(DEPTH):
        lam_init = 0.8 - 0.6 * math.exp(-0.3 * l)
        h = rmsnorm(x, norm_mix_g[l])
        proj = h @ w_in[l]
        dq, dk, dv, rq, rk, rv, rg = split_cols(proj)
        lam = (jnp.exp(jnp.sum(lambda_q1[l] * lambda_k1[l]))
               - jnp.exp(jnp.sum(lambda_q2[l] * lambda_k2[l])) + lam_init)
        da = diff_attention(dq.reshape(b, s, DA_HEADS, 2, DA_HEAD_DIM),
                            dk.reshape(b, s, DA_HEADS, 2, DA_HEAD_DIM),
                            dv.reshape(b, s, DA_HEADS, DA_V_DIM), lam, slopes)
        da = rmsnorm(da, da_subln_g[l]) * (1.0 - lam_init)
        ret = retention(rq.reshape(b, s, RET_HEADS, RET_QK_DIM),
                        rk.reshape(b, s, RET_HEADS, RET_QK_DIM),
                        rv.reshape(b, s, RET_HEADS, RET_V_DIM), log_gamma)
        ret = rmsnorm(ret).reshape(b, s, RET_HEADS * RET_V_DIM) * jax.nn.silu(rg)
        mixed = jnp.concatenate([da.reshape(b, s, DA_HEADS * DA_V_DIM), ret], axis=-1)
        x = x + mixed @ w_o[l]
        hx = rmsnorm(x, norm_x_g[l])
        hm = rmsnorm(mem, norm_mem_g[l])
        xq = (hx @ w_xq[l]).reshape(b, s, XATTN_HEADS, XATTN_HEAD_DIM)
        xk = (hm @ w_xk[l]).reshape(b, MEM_LEN, XATTN_HEADS, XATTN_HEAD_DIM)
        xv = (hm @ w_xv[l]).reshape(b, MEM_LEN, XATTN_HEADS, XATTN_HEAD_DIM)
        sc = jnp.einsum('bqhd,bkhd->bhqk', xq, xk).astype(jnp.float32) * XATTN_HEAD_DIM ** -0.5
        p = jax.nn.softmax(sc, axis=-1).astype(x.dtype)
        xo = jnp.einsum('bhqk,bkhd->bqhd', p, xv).reshape(b, s, D_MODEL)
        x = x + xo @ w_xo[l]
        hf = rmsnorm(x, norm_ffn_g[l])
        x = x + (jax.nn.silu(hf @ w_gate[l]) * (hf @ w_up[l])) @ w_down[l]
    return rmsnorm(x, norm_f_g)
```

```cpp
#include <hip/hip_runtime.h>
#include <cstdio>
#include <cstdint>
namespace pg8 {
#define PG8_LAS __attribute__((address_space(3)))
typedef unsigned short bf16_t;
typedef short bf16x8 __attribute__((ext_vector_type(8)));
typedef float f32x4 __attribute__((ext_vector_type(4)));
typedef unsigned u32x4 __attribute__((ext_vector_type(4)));
constexpr int BM = 256, BK = 64, HALF = 128, HTB = HALF * BK * 2  , STAGE_BYTES = 8 * HTB, NXCD = 8, WGM = 8;

__host__ __device__ __forceinline__ int lds_byte(int r, int c) { const int st = (r >> 4) * 2 + (c >> 5), rr = r & 15, cc = c & 31, ob = rr * 64 + cc * 2; return st * 1024 + (ob ^ (((ob >> 9) & 1) << 5)); }
__host__ __device__ __forceinline__ void stage_rc(int b, int& R, int& C) { const int st = b / 1024, sb = b % 1024, swz = sb ^ (((sb >> 9) & 1) << 5); R = (st >> 1) * 16 + swz / 64; C = (st & 1) * 32 + (swz % 64) / 2; }
__host__ __device__ __forceinline__ int perm32(int rho) { const int n = rho >> 4, i = rho & 15; return 8 * (i >> 2) + 4 * n + (i & 3); }

struct Unit { int pm, pn; };
struct Gemm { const bf16_t* A; const bf16_t* Bt; int M, N, K; };

struct StaticOrder {
    int nM, nN, nwg, G, c;
    __host__ __device__ void init(int M, int N, int G_, int c_) { nM = M / BM; nN = N / BM; nwg = nM * nN; G = G_; c = c_; }
    __host__ __device__ bool next(int i, Unit& u) const {
        const long L = (long)i * G + c; if (L >= nwg) return false;
        int wgid = (int)L; { const int q = nwg / NXCD, r = nwg % NXCD, xcd = wgid % NXCD, off = wgid / NXCD; wgid = (xcd < r ? xcd * (q + 1) : r * (q + 1) + (xcd - r) * q) + off; }
        const int nig = WGM * nN, gid = wgid / nig, fm = gid * WGM, gsz = (nM - fm) < WGM ? (nM - fm) : WGM;
        u.pm = fm + ((wgid % nig) % gsz); u.pn = (wgid % nig) / gsz; return true;
    }
    __device__ __forceinline__ void a_ready(const Unit&) const {}
    __device__ __forceinline__ void done(const Unit&) const {}
};

__device__ __forceinline__ unsigned cvt_pk_bf16(float lo, float hi) { unsigned r; asm volatile("v_cvt_pk_bf16_f32 %0, %1, %2" : "=v"(r) : "v"(lo), "v"(hi)); return r; }
typedef float f32x2 __attribute__((ext_vector_type(2)));
typedef unsigned u32x2 __attribute__((ext_vector_type(2)));
struct EpiBf16 {
    static constexpr bool PERM = true, AFTER_DRAIN = false;
    bf16_t* O; int ldc;
    __device__ __forceinline__ void operator()(const f32x4 (&acc)[2][2][4][2], const Unit& u, int wr, int wc, int fr, int fq) const {
        const int row0 = u.pm * BM + wr * 64 + fr, col0 = u.pn * BM + wc * 32 + 8 * fq;
#pragma unroll
        for (int ai = 0; ai < 2; ++ai)
#pragma unroll
            for (int m = 0; m < 4; ++m) { bf16_t* rowp = O + (size_t)(row0 + ai * HALF + m * 16) * ldc + col0;
#pragma unroll
                for (int bj = 0; bj < 2; ++bj) { const f32x4 v0 = acc[ai][bj][m][0], v1 = acc[ai][bj][m][1];
                    u32x4 w; w.x = cvt_pk_bf16(v0[0], v0[1]); w.y = cvt_pk_bf16(v0[2], v0[3]); w.z = cvt_pk_bf16(v1[0], v1[1]); w.w = cvt_pk_bf16(v1[2], v1[3]);
                    *(u32x4*)(rowp + bj * HALF) = w; } }
    }
};
struct EpiScaleBf16 {
    static constexpr bool PERM = true, AFTER_DRAIN = false;
    bf16_t* O; int ldc; const float* ssq;
    __device__ __forceinline__ void operator()(const f32x4 (&acc)[2][2][4][2], const Unit& u, int wr, int wc, int fr, int fq) const {
        const int row0 = u.pm * BM + wr * 64 + fr, col0 = u.pn * BM + wc * 32 + 8 * fq;
#pragma unroll
        for (int ai = 0; ai < 2; ++ai)
#pragma unroll
            for (int m = 0; m < 4; ++m) { const int row = row0 + ai * HALF + m * 16; bf16_t* rowp = O + (size_t)row * ldc + col0;
                const float r = 1.0f / sqrtf(ssq[row] * (1.0f / 2048.0f) + 1e-6f);
#pragma unroll
                for (int bj = 0; bj < 2; ++bj) { const f32x4 v0 = acc[ai][bj][m][0] * r, v1 = acc[ai][bj][m][1] * r;
                    u32x4 w; w.x = cvt_pk_bf16(v0[0], v0[1]); w.y = cvt_pk_bf16(v0[2], v0[3]); w.z = cvt_pk_bf16(v1[0], v1[1]); w.w = cvt_pk_bf16(v1[2], v1[3]);
                    *(u32x4*)(rowp + bj * HALF) = w; } }
    }
};
__device__ __forceinline__ float silu_f(float g) { return g * __builtin_amdgcn_rcpf(1.0f + __builtin_amdgcn_exp2f(-1.4426950408889634f * g)); }
struct EpiSwiGLU {
    static constexpr bool PERM = true, AFTER_DRAIN = false;
    bf16_t* O; int ldc; const float* ssq;
    __device__ __forceinline__ void operator()(const f32x4 (&acc)[2][2][4][2], const Unit& u, int wr, int wc, int fr, int fq) const {
        const int row0 = u.pm * BM + wr * 64 + fr, col0 = u.pn * HALF + wc * 32 + 8 * fq;
#pragma unroll
        for (int ai = 0; ai < 2; ++ai)
#pragma unroll
            for (int m = 0; m < 4; ++m) { const int row = row0 + ai * HALF + m * 16; bf16_t* rowp = O + (size_t)row * ldc + col0;
                const float r = 1.0f / sqrtf(ssq[row] * (1.0f / 2048.0f) + 1e-6f);
                float h[8];
#pragma unroll
                for (int n = 0; n < 2; ++n)
#pragma unroll
                    for (int j = 0; j < 4; ++j) { const float g = acc[ai][0][m][n][j] * r, up = acc[ai][1][m][n][j] * r; h[n * 4 + j] = silu_f(g) * up; }
                u32x4 w; w.x = cvt_pk_bf16(h[0], h[1]); w.y = cvt_pk_bf16(h[2], h[3]); w.z = cvt_pk_bf16(h[4], h[5]); w.w = cvt_pk_bf16(h[6], h[7]);
                *(u32x4*)rowp = w; }
    }
};
struct EpiRes {
    static constexpr bool PERM = false, AFTER_DRAIN = false;
    const float* base; float* out; bf16_t* xb; float* ssq; int ldc;
    __device__ __forceinline__ void operator()(const f32x4 (&acc)[2][2][4][2], const Unit& u, int wr, int wc, int fr, int fq) const {
        const int row0 = u.pm * BM + wr * 64 + fr, col0 = u.pn * BM + wc * 32 + 4 * fq;
#pragma unroll
        for (int ai = 0; ai < 2; ++ai)
#pragma unroll
            for (int m = 0; m < 4; ++m) { const int row = row0 + ai * HALF + m * 16; const size_t off = (size_t)row * ldc + col0; float s = 0.f;
#pragma unroll
                for (int bj = 0; bj < 2; ++bj)
#pragma unroll
                    for (int n = 0; n < 2; ++n) { const size_t o2 = off + bj * HALF + n * 16; const f32x4 v = *(const f32x4*)(base + o2) + acc[ai][bj][m][n];
                        *(f32x4*)(out + o2) = v; s += (v[0] * v[0] + v[1] * v[1]) + (v[2] * v[2] + v[3] * v[3]);
                        if (xb) { u32x2 w; w.x = cvt_pk_bf16(v[0], v[1]); w.y = cvt_pk_bf16(v[2], v[3]); *(u32x2*)(xb + o2) = w; } }
                s += __shfl_xor(s, 16); s += __shfl_xor(s, 32);
                if (fq == 0) atomicAdd(ssq + row, s);
                if (m & 1) asm volatile("" ::: "memory"); }
    }
};
template <class Epi, class Sched, bool ALIGN_EPI = false, bool SP2 = false>
__device__ __forceinline__ void gemm_phase(PG8_LAS unsigned char* lds, const Gemm g, const Sched& S, const Epi& E) {
    const int tid = threadIdx.x, wid = __builtin_amdgcn_readfirstlane(tid >> 6), lane = tid & 63, wr = wid >> 2, wc = wid & 3, fr = lane & 15, fq = lane >> 4;
    const int K = g.K, nt = K / BK;
    unsigned voffA[2], voffB[2];
#pragma unroll
    for (int i = 0; i < 2; ++i) { int R, C; stage_rc(tid * 16 + i * 8192, R, C); const int Rb = Epi::PERM ? ((R & ~31) + perm32(R & 31)) : R;
        voffA[i] = (unsigned)(R * K + C) * 2u; voffB[i] = (unsigned)(Rb * K + C) * 2u; }
    const size_t kstep = (size_t)(BK * 2);
    const size_t hstep = (size_t)HALF * K * 2;
    const size_t tstep = 2 * hstep;
    const unsigned ldsw = (unsigned)wid * 1024u;
    const int aoff = lds_byte(wr * 64 + fr, fq * 8), boff = lds_byte(wc * 32 + fr, fq * 8);
#define PG8_SA(b, h) (((b) * 2 + (h)) * HTB)
#define PG8_SB(b, h) ((4 + (b) * 2 + (h)) * HTB)
#define PG8_STAGE(bufoff, gbase, voff) do { _Pragma("unroll") for (int _i = 0; _i < 2; ++_i) \
        __builtin_amdgcn_global_load_lds((const unsigned*)((const char*)(gbase) + (voff)[_i]), (PG8_LAS unsigned*)(lds + (bufoff) + ldsw + _i * 8192), 16, 0, 0); } while (0)
#define PG8_LDA(dst, b, h) do { _Pragma("unroll") for (int m = 0; m < 4; ++m) _Pragma("unroll") for (int k = 0; k < 2; ++k) dst[m][k] = *(const PG8_LAS bf16x8*)(lds + PG8_SA(b, h) + aoff + m * 2048 + k * 1024); } while (0)
#define PG8_LDB(dst, b, h) do { _Pragma("unroll") for (int n = 0; n < 2; ++n) _Pragma("unroll") for (int k = 0; k < 2; ++k) dst[n][k] = *(const PG8_LAS bf16x8*)(lds + PG8_SB(b, h) + boff + n * 2048 + k * 1024); } while (0)
#define PG8_MMA(ai, bj, At, Bt) do { __builtin_amdgcn_s_setprio(1); _Pragma("unroll") for (int m = 0; m < 4; ++m) _Pragma("unroll") for (int n = 0; n < 2; ++n) _Pragma("unroll") for (int k = 0; k < 2; ++k) \
        acc[ai][bj][m][n] = __builtin_amdgcn_mfma_f32_16x16x32_bf16(Bt[n][k], At[m][k], acc[ai][bj][m][n], 0, 0, 0); __builtin_amdgcn_s_setprio(0); } while (0)
#define PG8_WAIT_V(n) asm volatile("s_waitcnt vmcnt(" #n ")" ::: "memory")
#define PG8_WAIT_L(n) asm volatile("s_waitcnt lgkmcnt(" #n ")" ::: "memory")
#define PG8_BAR __builtin_amdgcn_s_barrier()
#define PG8_SCHED __builtin_amdgcn_sched_barrier(0)
    Unit cur, nxt; int ui = 0;
    if (!S.next(0, cur)) return;
    f32x4 acc[2][2][4][2];
#pragma unroll
    for (int a = 0; a < 2; ++a)
#pragma unroll
        for (int b = 0; b < 2; ++b)
#pragma unroll
            for (int m = 0; m < 4; ++m)
#pragma unroll
                for (int n = 0; n < 2; ++n) acc[a][b][m][n] = (f32x4){0.f, 0.f, 0.f, 0.f};
    bf16x8 At[4][2], B0[2][2], B1[2][2];
    const char* cA = (const char*)g.A + (size_t)cur.pm * tstep; const char* cB = (const char*)g.Bt + (size_t)cur.pn * tstep;
    S.a_ready(cur);
    if constexpr (SP2) {
        PG8_STAGE(PG8_SB(0, 0), cB, voffB); PG8_STAGE(PG8_SB(0, 1), cB + hstep, voffB); PG8_STAGE(PG8_SA(0, 0), cA, voffA); PG8_STAGE(PG8_SA(0, 1), cA + hstep, voffA);
        if (wr == 1) PG8_BAR;
        PG8_WAIT_V(2); PG8_BAR;
        PG8_STAGE(PG8_SB(1, 0), cB + kstep, voffB); PG8_STAGE(PG8_SA(1, 0), cA + kstep, voffA); PG8_STAGE(PG8_SB(1, 1), cB + hstep + kstep, voffB);
        PG8_WAIT_V(6); PG8_BAR;
    } else {
        PG8_STAGE(PG8_SB(0, 0), cB, voffB); PG8_STAGE(PG8_SA(0, 0), cA, voffA); PG8_STAGE(PG8_SB(0, 1), cB + hstep, voffB); PG8_STAGE(PG8_SA(0, 1), cA + hstep, voffA);
        if (wr == 1) PG8_BAR;
        PG8_WAIT_V(4); PG8_BAR;
        PG8_STAGE(PG8_SB(1, 0), cB + kstep, voffB); PG8_STAGE(PG8_SA(1, 0), cA + kstep, voffA); PG8_STAGE(PG8_SB(1, 1), cB + hstep + kstep, voffB);
        PG8_WAIT_V(6); PG8_BAR;
    }
    for (;;) {
        const bool has_next = S.next(ui + 1, nxt);
        const char* nA = has_next ? (const char*)g.A + (size_t)nxt.pm * tstep : cA; const char* nB = has_next ? (const char*)g.Bt + (size_t)nxt.pn * tstep : cB;
        for (int t = 0; t < nt; t += 2) {
            const bool last = (t == nt - 2);
            const char* a1 = cA + (size_t)(t + 1) * kstep;
            const char* a2 = last ? nA : cA + (size_t)(t + 2) * kstep; const char* b2 = last ? nB : cB + (size_t)(t + 2) * kstep;
            const char* a3 = a2 + kstep; const char* b3 = b2 + kstep;
            if (last && has_next) S.a_ready(nxt);
            if constexpr (SP2) {
            PG8_LDB(B0, 0, 0); PG8_LDB(B1, 0, 1); PG8_SCHED; PG8_LDA(At, 0, 0); PG8_STAGE(PG8_SA(1, 1), a1 + hstep, voffA);
            PG8_WAIT_V(8); PG8_WAIT_L(0); PG8_BAR; PG8_MMA(0, 0, At, B0); PG8_MMA(0, 1, At, B1); PG8_BAR; PG8_SCHED;
            PG8_LDA(At, 0, 1); PG8_STAGE(PG8_SB(0, 0), b2, voffB); PG8_STAGE(PG8_SB(0, 1), b2 + hstep, voffB); PG8_STAGE(PG8_SA(0, 0), a2, voffA);
            PG8_WAIT_V(8); PG8_WAIT_L(0); PG8_BAR; PG8_MMA(1, 0, At, B0); PG8_MMA(1, 1, At, B1); PG8_BAR; PG8_SCHED;
            PG8_LDB(B0, 1, 0); PG8_LDB(B1, 1, 1); PG8_SCHED; PG8_LDA(At, 1, 0); PG8_STAGE(PG8_SA(0, 1), a2 + hstep, voffA);
            PG8_WAIT_V(8); PG8_WAIT_L(0); PG8_BAR; PG8_MMA(0, 0, At, B0); PG8_MMA(0, 1, At, B1); PG8_BAR; PG8_SCHED;
            PG8_LDA(At, 1, 1); PG8_STAGE(PG8_SB(1, 0), b3, voffB); PG8_STAGE(PG8_SB(1, 1), b3 + hstep, voffB); PG8_STAGE(PG8_SA(1, 0), a3, voffA);
            PG8_WAIT_V(8); PG8_WAIT_L(0); PG8_BAR; PG8_MMA(1, 0, At, B0); PG8_MMA(1, 1, At, B1); PG8_BAR; PG8_SCHED;
            } else {
            PG8_LDB(B0, 0, 0); PG8_SCHED; PG8_LDA(At, 0, 0); PG8_STAGE(PG8_SA(1, 1), a1 + hstep, voffA);
            PG8_WAIT_L(8); PG8_BAR; PG8_WAIT_L(0); PG8_MMA(0, 0, At, B0); PG8_BAR; PG8_SCHED;
            PG8_LDB(B1, 0, 1); PG8_STAGE(PG8_SB(0, 0), b2, voffB);
            PG8_BAR; PG8_WAIT_L(0); PG8_MMA(0, 1, At, B1); PG8_BAR;
            PG8_LDA(At, 0, 1); PG8_STAGE(PG8_SA(0, 0), a2, voffA);
            PG8_BAR; PG8_WAIT_L(0); PG8_MMA(1, 0, At, B0); PG8_BAR; PG8_SCHED;
            PG8_STAGE(PG8_SB(0, 1), b2 + hstep, voffB);
            PG8_WAIT_V(6); PG8_BAR; PG8_MMA(1, 1, At, B1); PG8_BAR;
            PG8_LDB(B0, 1, 0); PG8_SCHED; PG8_LDA(At, 1, 0); PG8_STAGE(PG8_SA(0, 1), a2 + hstep, voffA);
            PG8_WAIT_L(8); PG8_BAR; PG8_WAIT_L(0); PG8_MMA(0, 0, At, B0); PG8_BAR; PG8_SCHED;
            PG8_LDB(B1, 1, 1); PG8_STAGE(PG8_SB(1, 0), b3, voffB);
            PG8_BAR; PG8_WAIT_L(0); PG8_MMA(0, 1, At, B1); PG8_BAR;
            PG8_LDA(At, 1, 1); PG8_STAGE(PG8_SA(1, 0), a3, voffA);
            PG8_BAR; PG8_WAIT_L(0); PG8_MMA(1, 0, At, B0); PG8_BAR; PG8_SCHED;
            PG8_STAGE(PG8_SB(1, 1), b3 + hstep, voffB);
            PG8_WAIT_V(6); PG8_BAR; PG8_MMA(1, 1, At, B1); PG8_BAR;
            }
        }
        if constexpr (ALIGN_EPI) { if (wr == 0) PG8_BAR; }
        if constexpr (!Epi::AFTER_DRAIN) { E(acc, cur, wr, wc, fr, fq); S.done(cur); }
        if (!has_next) break;
#pragma unroll
        for (int a = 0; a < 2; ++a)
#pragma unroll
            for (int b = 0; b < 2; ++b)
#pragma unroll
                for (int m = 0; m < 4; ++m)
#pragma unroll
                    for (int n = 0; n < 2; ++n) acc[a][b][m][n] = (f32x4){0.f, 0.f, 0.f, 0.f};
        cur = nxt; cA = nA; cB = nB; ++ui;
        if constexpr (ALIGN_EPI) { if (wr == 1) PG8_BAR; }
    }
    PG8_WAIT_V(0);
    if constexpr (!ALIGN_EPI) { if (wr == 0) PG8_BAR; }
    PG8_BAR;
    if constexpr (Epi::AFTER_DRAIN) { E.fused(acc, cur, wr, wc, fr, fq, lds, wid, lane); S.done(cur); }
#undef PG8_SA
#undef PG8_SB
#undef PG8_STAGE
#undef PG8_LDA
#undef PG8_LDB
#undef PG8_MMA
#undef PG8_WAIT_V
#undef PG8_WAIT_L
#undef PG8_BAR
#undef PG8_SCHED
}
}

constexpr int NWAVES = 8;
constexpr int BATCH = 4, SEQ = 2048, DM = 2048, MTOK = BATCH * SEQ, MEMLEN = 256, MMEM = BATCH * MEMLEN, INC = 6144, DFF = 5632;
constexpr float NORM_EPS = 1e-6f;
constexpr size_t MiB = 1u << 20;
constexpr size_t WS_CTL = 0, CTL_ZERO_BYTES = 64 * 1024;
constexpr size_t WS_SSQ = 1 * MiB;
constexpr size_t WS_WIN = 2 * MiB, WS_WO = 26 * MiB, WS_WXQ = 34 * MiB, WS_WXKV = 42 * MiB, WS_WXO = 58 * MiB, WS_WGU = 66 * MiB, WS_WD = 110 * MiB;
constexpr size_t WS_HM = 132 * MiB, WS_XKV = 136 * MiB;
constexpr size_t WS_B = 144 * MiB;
constexpr size_t WS_C = 176 * MiB;
constexpr size_t WS_A = 208 * MiB;
constexpr size_t WS_END = 304 * MiB;
constexpr int CW_BAR = 4096;
constexpr int RING_OFF = 0, RING_BYTES = 131072;
constexpr int NAIVE_WAVE_BYTES = 17408;
constexpr int LDSCTL_OFF = 143360, MISC_OFF = LDSCTL_OFF + 320;
constexpr int LDS_BYTES = 147456;
static_assert(NWAVES * NAIVE_WAVE_BYTES <= LDSCTL_OFF && MISC_OFF + 128 <= LDS_BYTES, "LDS map");

#define GAS __attribute__((address_space(1)))
#define LAS __attribute__((address_space(3)))
typedef unsigned short bf16;
typedef unsigned v4u __attribute__((ext_vector_type(4)));
typedef unsigned v2u __attribute__((ext_vector_type(2)));
typedef float f32x4 __attribute__((ext_vector_type(4)));
typedef GAS unsigned gu32;
#define RLX_AGENT __ATOMIC_RELAXED, __HIP_MEMORY_SCOPE_AGENT
#define LDS_WAIT() asm volatile("s_waitcnt lgkmcnt(0)" ::: "memory")
#define VM_WAIT() asm volatile("s_waitcnt vmcnt(0)" ::: "memory")
__device__ __forceinline__ unsigned f2bf(float f) { unsigned u = __builtin_bit_cast(unsigned, f); return (u + 0x7fffu + ((u >> 16) & 1u)) >> 16; }
__device__ __forceinline__ unsigned pk2(float lo, float hi) { return f2bf(lo) | (f2bf(hi) << 16); }
__device__ __forceinline__ float bflo(unsigned w) { return __uint_as_float(w << 16); }
__device__ __forceinline__ float bfhi(unsigned w) { return __uint_as_float(w & 0xffff0000u); }
__device__ __forceinline__ float bf2f(bf16 v) { return __uint_as_float(((unsigned)v) << 16); }

#define XB_TMO      128
#define XB_XCNT(j)  (256  + 64 * (j))
#define XB_XSUB(j)  (1280 + 64 * (j))
#define XB_XGEN(j)  (2304 + 64 * (j))
#define XB_TOP      3328
#define XB_TOPGEN   3392
#define XCD_BAR_WORDS 3456
#define XB_SPIN_CAP (1u << 22)
__device__ __forceinline__ unsigned xb_ld(unsigned* p)              { return __hip_atomic_load(p, __ATOMIC_RELAXED, __HIP_MEMORY_SCOPE_AGENT); }
__device__ __forceinline__ unsigned xb_add(unsigned* p, unsigned v) { return __hip_atomic_fetch_add(p, v, __ATOMIC_RELAXED, __HIP_MEMORY_SCOPE_AGENT); }
__device__ __forceinline__ unsigned xb_xcc_id() { return (unsigned)__builtin_amdgcn_s_getreg((3 << 11) | 20) & 0xFu; }
#define XB_SPIN(cond, bar) do { unsigned _sp = 0; while (cond) { __builtin_amdgcn_s_sleep(1); \
    if ((++_sp & 255u) == 0u) { if (xb_ld(&(bar)[XB_TMO])) break; if (_sp > XB_SPIN_CAP) { atomicAdd(&(bar)[XB_TMO], 1u); break; } } } } while (0)
struct XcdBarrier { unsigned* bar; unsigned x; volatile LAS unsigned* st; };
__device__ __forceinline__ XcdBarrier xcd_barrier_post(unsigned* bar, volatile LAS unsigned* st) {
    XcdBarrier b; b.bar = bar; b.x = xb_xcc_id(); b.st = st;
    if (threadIdx.x == 0) (void)xb_add(&bar[XB_XCNT(b.x)], 1u);
    return b;
}
__device__ __forceinline__ void xcd_barrier_complete(unsigned* bar, unsigned x, unsigned& nloc, unsigned& nx) {
    const unsigned G = gridDim.x * gridDim.y * gridDim.z;
    unsigned sum, cnt, mine, sp = 0u;
    for (;;) {
        sum = 0u; cnt = 0u; mine = 0u;
#pragma unroll
        for (unsigned j = 0; j < 16; ++j) { const unsigned c = xb_ld(&bar[XB_XCNT(j)]); sum += c; cnt += (c > 0u) ? 1u : 0u; mine = (j == x) ? c : mine; }
        if (sum == G) break;
        __builtin_amdgcn_s_sleep(1);
        if ((++sp & 255u) == 0u) { if (xb_ld(&bar[XB_TMO])) break; if (sp > XB_SPIN_CAP) { atomicAdd(&bar[XB_TMO], 1u); break; } }
    }
    nloc = mine > 0u ? mine : 1u; nx = cnt > 0u ? cnt : 1u;
}
__device__ __forceinline__ void xcd_barrier(const XcdBarrier& b) {
    asm volatile("s_waitcnt vmcnt(0)" ::: "memory");
    __syncthreads();
    if (threadIdx.x == 0) {
        unsigned* bar = b.bar;
        __builtin_amdgcn_s_waitcnt(0);
        unsigned nloc = b.st[0], nx = b.st[1];
        if (nloc == 0u) { xcd_barrier_complete(bar, b.x, nloc, nx); b.st[0] = nloc; b.st[1] = nx; }
        const unsigned old = xb_add(&bar[XB_XSUB(b.x)], 1u);
        const unsigned gen = old / nloc;
        if (old + 1u == (gen + 1u) * nloc) {
            __builtin_amdgcn_fence(__ATOMIC_RELEASE, "agent");
            asm volatile("s_waitcnt vmcnt(0)" ::: "memory");
            const unsigned og = xb_add(&bar[XB_TOP], 1u);
            const unsigned tg = og / nx;
            if (og + 1u == (tg + 1u) * nx) xb_add(&bar[XB_TOPGEN], 1u);
            else XB_SPIN(xb_ld(&bar[XB_TOPGEN]) == tg, bar);
            __builtin_amdgcn_fence(__ATOMIC_ACQUIRE, "agent");
            xb_add(&bar[XB_XGEN(b.x)], 1u);
            asm volatile("s_waitcnt vmcnt(0)" ::: "memory");
        } else {
            XB_SPIN(xb_ld(&bar[XB_XGEN(b.x)]) == gen, bar);
            __builtin_amdgcn_fence(__ATOMIC_ACQUIRE, "agent");
            asm volatile("s_waitcnt vmcnt(0)" ::: "memory");
        }
    }
    __syncthreads();
}

__device__ __forceinline__ float wave_sum(float v) {
#pragma unroll
    for (int o = 1; o < 64; o <<= 1) v += __shfl_xor(v, o);
    return v;
}
__device__ __forceinline__ float wave_max(float v) {
#pragma unroll
    for (int o = 1; o < 64; o <<= 1) v = fmaxf(v, __shfl_xor(v, o));
    return v;
}

__device__ __forceinline__ void p0_transpose_item(const float* W, int K, int N, bf16* WT, int mode, int row_off, const float* gain, LAS float* scr, int item, int lane) {
    const int nblk = N / 32, kb = item / nblk, nb = item % nblk, k0 = 64 * kb, n0 = 32 * nb;
#pragma unroll 8
    for (int i = 0; i < 32; ++i) { const int kk = 2 * i + (lane >> 5); float w = W[(size_t)(k0 + kk) * N + n0 + (lane & 31)]; if (gain) w *= gain[k0 + kk]; scr[kk * 33 + (lane & 31)] = w; }
    LDS_WAIT(); asm volatile("" ::: "memory");
    const int c = lane & 7;
    const int r0 = (mode == 0) ? (row_off + n0) : (256 * (n0 >> 7) + 128 * (mode - 1) + (n0 & 127));
#pragma unroll
    for (int j = 0; j < 4; ++j) { const int n = (lane >> 3) + 8 * j; const LAS float* s = scr + (8 * c) * 33 + n;
        v4u o; o.x = pk2(s[0 * 33], s[1 * 33]); o.y = pk2(s[2 * 33], s[3 * 33]); o.z = pk2(s[4 * 33], s[5 * 33]); o.w = pk2(s[6 * 33], s[7 * 33]);
        *(v4u*)(WT + (size_t)(r0 + n) * K + k0 + 8 * c) = o; }
    LDS_WAIT(); asm volatile("" ::: "memory");
}
__device__ __forceinline__ void rms_row_to_bf16(const float* xrow, const float* g, bf16* orow, int lane) {
    const f32x4* xr = (const f32x4*)xrow + lane; const f32x4* gr = (const f32x4*)g + lane;
    f32x4 v[8]; float s = 0.f;
#pragma unroll
    for (int j = 0; j < 8; ++j) { v[j] = xr[64 * j]; s += (v[j].x * v[j].x + v[j].y * v[j].y) + (v[j].z * v[j].z + v[j].w * v[j].w); }
    const float r = 1.0f / sqrtf(wave_sum(s) * (1.f / DM) + NORM_EPS);
    v2u* o8 = (v2u*)orow + lane;
#pragma unroll
    for (int j = 0; j < 8; ++j) { const f32x4 gg = gr[64 * j]; v2u w; w.x = pk2(v[j].x * r * gg.x, v[j].y * r * gg.y); w.y = pk2(v[j].z * r * gg.z, v[j].w * r * gg.w); o8[64 * j] = w; }
}

__device__ __forceinline__ float dot_lds_bf16(const LAS float* q, const bf16* k, int n) {
    float s = 0.f;
    for (int d = 0; d < n; d += 8) { const v4u w = *(const v4u*)(k + d);
        s += q[d] * bflo(w.x) + q[d + 1] * bfhi(w.x) + q[d + 2] * bflo(w.y) + q[d + 3] * bfhi(w.y) + q[d + 4] * bflo(w.z) + q[d + 5] * bfhi(w.z) + q[d + 6] * bflo(w.w) + q[d + 7] * bfhi(w.w); }
    return s;
}
__device__ __forceinline__ void naive_da_item(const bf16* P, bf16* MIX, const float* subg, float lam, int b, int h, int i, LAS float* scr, int lane) {
    const size_t rowq = (size_t)(b * SEQ + i) * INC;
    LAS float* qs = scr; LAS float* tmp = scr + 256; LAS float* as = scr + 256 + 2048;
    for (int t = lane; t < 256; t += 64) qs[t] = bf2f(P[rowq + h * 256 + t]);
    LDS_WAIT(); asm volatile("" ::: "memory");
    const float slope = exp2f(-2.0f * (float)(h + 1)), scale = 0.08838834764831845f;
    for (int c = 0; c < 2; ++c) {
        float mx = -3.0e38f;
        for (int j = lane; j <= i; j += 64) {
            const bf16* kr = P + (size_t)(b * SEQ + j) * INC + 1024 + h * 256 + c * 128;
            float s = dot_lds_bf16(qs + c * 128, kr, 128);
            s = s * scale - slope * (float)(i - j);
            tmp[j] = s; mx = fmaxf(mx, s);
        }
        mx = wave_max(mx);
        float sum = 0.f;
        for (int j = lane; j <= i; j += 64) { const float p = __expf(tmp[j] - mx); tmp[j] = p; sum += p; }
        sum = wave_sum(sum);
        const float inv = 1.0f / sum;
        for (int j = lane; j <= i; j += 64) { if (c == 0) as[j] = tmp[j] * inv; else as[j] -= lam * tmp[j] * inv; }
    }
    LDS_WAIT(); asm volatile("" ::: "memory");
    float o0 = 0.f, o1 = 0.f, o2 = 0.f, o3 = 0.f;
    const bf16* vb = P + (size_t)(b * SEQ) * INC + 2048 + h * 256 + 4 * lane;
    for (int j = 0; j <= i; ++j) { const float a = as[j]; const v2u w = *(const v2u*)(vb + (size_t)j * INC);
        o0 += a * bflo(w.x); o1 += a * bfhi(w.x); o2 += a * bflo(w.y); o3 += a * bfhi(w.y); }
    const float ss = wave_sum(o0 * o0 + o1 * o1 + o2 * o2 + o3 * o3);
    const float r = 0.8f / sqrtf(ss * (1.0f / 256.0f) + NORM_EPS);
    const f32x4 g = *(const f32x4*)(subg + 4 * lane);
    v2u w; w.x = pk2(o0 * r * g.x, o1 * r * g.y); w.y = pk2(o2 * r * g.z, o3 * r * g.w);
    *(v2u*)(MIX + (size_t)(b * SEQ + i) * DM + h * 256 + 4 * lane) = w;
    LDS_WAIT(); asm volatile("" ::: "memory");
}
__device__ __forceinline__ void naive_ret_item(const bf16* P, bf16* MIX, int b, int h, int i, LAS float* scr, int lane) {
    const size_t rowq = (size_t)(b * SEQ + i) * INC;
    LAS float* qs = scr; LAS float* as = scr + 256;
    for (int t = lane; t < 128; t += 64) qs[t] = bf2f(P[rowq + 3072 + h * 128 + t]);
    LDS_WAIT(); asm volatile("" ::: "memory");
    const float lg = logf(1.0f - exp2f(-5.0f - (float)h)), scale = 0.08838834764831845f;
    for (int j = lane; j <= i; j += 64) {
        const bf16* kr = P + (size_t)(b * SEQ + j) * INC + 3584 + h * 128;
        const float s = dot_lds_bf16(qs, kr, 128);
        as[j] = s * scale * __expf(lg * (float)(i - j));
    }
    LDS_WAIT(); asm volatile("" ::: "memory");
    float o0 = 0.f, o1 = 0.f, o2 = 0.f, o3 = 0.f;
    const bf16* vb = P + (size_t)(b * SEQ) * INC + 4096 + h * 256 + 4 * lane;
    for (int j = 0; j <= i; ++j) { const float a = as[j]; const v2u w = *(const v2u*)(vb + (size_t)j * INC);
        o0 += a * bflo(w.x); o1 += a * bfhi(w.x); o2 += a * bflo(w.y); o3 += a * bfhi(w.y); }
    const float ss = wave_sum(o0 * o0 + o1 * o1 + o2 * o2 + o3 * o3);
    const float r = 1.0f / sqrtf(ss * (1.0f / 256.0f) + NORM_EPS);
    const v2u gw = *(const v2u*)(P + rowq + 5120 + h * 256 + 4 * lane);
    const float g0 = bflo(gw.x), g1 = bfhi(gw.x), g2 = bflo(gw.y), g3 = bfhi(gw.y);
    v2u w; w.x = pk2(o0 * r * (g0 / (1.0f + __expf(-g0))), o1 * r * (g1 / (1.0f + __expf(-g1)))); w.y = pk2(o2 * r * (g2 / (1.0f + __expf(-g2))), o3 * r * (g3 / (1.0f + __expf(-g3))));
    *(v2u*)(MIX + (size_t)(b * SEQ + i) * DM + 1024 + h * 256 + 4 * lane) = w;
    LDS_WAIT(); asm volatile("" ::: "memory");
}
__device__ __forceinline__ void naive_xattn_item(const bf16* XQ, const bf16* XKV, bf16* XO, int b, int h, int i, LAS float* scr, int lane) {
    const size_t rowq = (size_t)(b * SEQ + i) * DM + h * 512;
    LAS float* qs = scr; LAS float* as = scr + 512;
    for (int t = lane; t < 512; t += 64) qs[t] = bf2f(XQ[rowq + t]);
    LDS_WAIT(); asm volatile("" ::: "memory");
    const float scale = 0.044194173824159216f;
    float sc[4]; float mx = -3.0e38f;
#pragma unroll
    for (int t = 0; t < 4; ++t) { const int j = lane + 64 * t; sc[t] = dot_lds_bf16(qs, XKV + (size_t)(b * MEMLEN + j) * 4096 + h * 512, 512) * scale; mx = fmaxf(mx, sc[t]); }
    mx = wave_max(mx);
    float sum = 0.f;
#pragma unroll
    for (int t = 0; t < 4; ++t) { sc[t] = __expf(sc[t] - mx); sum += sc[t]; }
    sum = wave_sum(sum);
    const float inv = 1.0f / sum;
#pragma unroll
    for (int t = 0; t < 4; ++t) as[lane + 64 * t] = sc[t] * inv;
    LDS_WAIT(); asm volatile("" ::: "memory");
    float o[8];
#pragma unroll
    for (int e = 0; e < 8; ++e) o[e] = 0.f;
    const bf16* vb = XKV + (size_t)(b * MEMLEN) * 4096 + 2048 + h * 512 + 8 * lane;
    for (int j = 0; j < MEMLEN; ++j) { const float a = as[j]; const v4u w = *(const v4u*)(vb + (size_t)j * 4096);
        o[0] += a * bflo(w.x); o[1] += a * bfhi(w.x); o[2] += a * bflo(w.y); o[3] += a * bfhi(w.y); o[4] += a * bflo(w.z); o[5] += a * bfhi(w.z); o[6] += a * bflo(w.w); o[7] += a * bfhi(w.w); }
    v4u w; w.x = pk2(o[0], o[1]); w.y = pk2(o[2], o[3]); w.z = pk2(o[4], o[5]); w.w = pk2(o[6], o[7]);
    *(v4u*)(XO + rowq + 8 * lane) = w;
    LDS_WAIT(); asm volatile("" ::: "memory");
}

struct Args { const float* in[21]; float* out; unsigned char* ws; };
__global__ void __launch_bounds__(NWAVES * 64, 2) mega_fwd(Args args) {
    extern __shared__ __attribute__((aligned(16))) unsigned char lds[];
    LAS unsigned char* L = (LAS unsigned char*)lds;
    volatile LAS unsigned* MISC = (volatile LAS unsigned*)(L + MISC_OFF);
    const int tid = threadIdx.x, lane = tid & 63, wave = __builtin_amdgcn_readfirstlane(tid >> 6);
    const int G = gridDim.x; const int bx = blockIdx.x; const int vcu = (G % 8 == 0) ? (bx % 8) * (G / 8) + bx / 8 : bx;
    unsigned char* ws = args.ws;
    gu32* ctl = (gu32*)(ws + WS_CTL);
    const float* x = args.in[0]; const float* mem = args.in[1];
    float* out = args.out;
    bf16* Win_t = (bf16*)(ws + WS_WIN); bf16* Wo_t = (bf16*)(ws + WS_WO); bf16* Wxq_t = (bf16*)(ws + WS_WXQ); bf16* Wxkv_t = (bf16*)(ws + WS_WXKV);
    bf16* Wxo_t = (bf16*)(ws + WS_WXO); bf16* Wgu_t = (bf16*)(ws + WS_WGU); bf16* Wd_t = (bf16*)(ws + WS_WD);
    bf16* HM = (bf16*)(ws + WS_HM); bf16* XKV = (bf16*)(ws + WS_XKV); bf16* XB = (bf16*)(ws + WS_B); bf16* MIX = (bf16*)(ws + WS_C);
    bf16* PROJ = (bf16*)(ws + WS_A); bf16* XQ = (bf16*)(ws + WS_A); bf16* XO = (bf16*)(ws + WS_A + 32 * MiB); bf16* HFF = (bf16*)(ws + WS_A);
    float* ssq1 = (float*)(ws + WS_SSQ); float* ssq2 = ssq1 + MTOK; float* ssq3 = ssq2 + MTOK;
    for (int u = tid; u < (LDS_BYTES - LDSCTL_OFF) / 4; u += NWAVES * 64) ((LAS unsigned*)(L + LDSCTL_OFF))[u] = 0u;
    __syncthreads();
    XcdBarrier bar = xcd_barrier_post((unsigned*)(ctl + CW_BAR), MISC + 8);
    const int gw = vcu * NWAVES + wave, NGW = G * NWAVES;

    {
        LAS float* scr = (LAS float*)(L + RING_OFF + wave * 16384);
        constexpr int I_IN = (DM / 64) * (INC / 32), I_SQ = (DM / 64) * (DM / 32), I_FF = (DM / 64) * (DFF / 32), I_DN = (DFF / 64) * (DM / 32);
        constexpr int NITEMS = I_IN + 5 * I_SQ + 2 * I_FF + I_DN;
        for (int it = gw; it < NITEMS; it += NGW) {
            int r = it;
            if (r < I_IN) { p0_transpose_item(args.in[3], DM, INC, Win_t, 0, 0, nullptr, scr, r, lane); continue; } r -= I_IN;
            if (r < I_SQ) { p0_transpose_item(args.in[9], DM, DM, Wo_t, 0, 0, nullptr, scr, r, lane); continue; } r -= I_SQ;
            if (r < I_SQ) { p0_transpose_item(args.in[12], DM, DM, Wxq_t, 0, 0, args.in[10], scr, r, lane); continue; } r -= I_SQ;
            if (r < I_SQ) { p0_transpose_item(args.in[13], DM, DM, Wxkv_t, 0, 0, nullptr, scr, r, lane); continue; } r -= I_SQ;
            if (r < I_SQ) { p0_transpose_item(args.in[14], DM, DM, Wxkv_t, 0, DM, nullptr, scr, r, lane); continue; } r -= I_SQ;
            if (r < I_SQ) { p0_transpose_item(args.in[15], DM, DM, Wxo_t, 0, 0, nullptr, scr, r, lane); continue; } r -= I_SQ;
            if (r < I_FF) { p0_transpose_item(args.in[17], DM, DFF, Wgu_t, 1, 0, args.in[16], scr, r, lane); continue; } r -= I_FF;
            if (r < I_FF) { p0_transpose_item(args.in[18], DM, DFF, Wgu_t, 2, 0, args.in[16], scr, r, lane); continue; } r -= I_FF;
            p0_transpose_item(args.in[19], DFF, DM, Wd_t, 0, 0, nullptr, scr, r, lane);
        }
        for (int m = gw; m < MTOK; m += NGW) rms_row_to_bf16(x + (size_t)m * DM, args.in[2], XB + (size_t)m * DM, lane);
        for (int m = gw; m < MMEM; m += NGW) rms_row_to_bf16(mem + (size_t)m * DM, args.in[11], HM + (size_t)m * DM, lane);
        for (int i = bx * (NWAVES * 64) + tid; i < 3 * MTOK; i += G * NWAVES * 64) ssq1[i] = 0.f;
    }
    xcd_barrier(bar);

    {
        pg8::Gemm g{XB, Win_t, MTOK, INC, DM}; pg8::StaticOrder S; S.init(MTOK, INC, G, bx);
        pg8::EpiBf16 E{PROJ, INC};
        pg8::gemm_phase<pg8::EpiBf16, pg8::StaticOrder, true, true>(L + RING_OFF, g, S, E);
    }
    {
        pg8::Gemm g{HM, Wxkv_t, MMEM, 2 * DM, DM}; pg8::StaticOrder S; S.init(MMEM, 2 * DM, G, bx);
        pg8::EpiBf16 E{XKV, 2 * DM};
        pg8::gemm_phase<pg8::EpiBf16, pg8::StaticOrder, true, true>(L + RING_OFF, g, S, E);
    }
    xcd_barrier(bar);

    {
        LAS float* scr = (LAS float*)(L + wave * NAIVE_WAVE_BYTES);
        float lam;
        { const float a1 = args.in[4][lane] * args.in[5][lane] + args.in[4][lane + 64] * args.in[5][lane + 64];
          const float a2 = args.in[6][lane] * args.in[7][lane] + args.in[6][lane + 64] * args.in[7][lane + 64];
          lam = __expf(wave_sum(a1)) - __expf(wave_sum(a2)) + 0.2f; }
        for (int it = gw; it < 16 * SEQ; it += NGW) {
            const int k = it >> 11, bh = k, i = (k & 1) ? (SEQ - 1 - (it & (SEQ - 1))) : (it & (SEQ - 1));
            naive_da_item(PROJ, MIX, args.in[8], lam, bh >> 2, bh & 3, i, scr, lane);
            naive_ret_item(PROJ, MIX, bh >> 2, bh & 3, SEQ - 1 - i, scr, lane);
        }
    }
    xcd_barrier(bar);

    {
        pg8::Gemm g{MIX, Wo_t, MTOK, DM, DM}; pg8::StaticOrder S; S.init(MTOK, DM, G, bx);
        pg8::EpiRes E{x, out, XB, ssq1, DM};
        pg8::gemm_phase<pg8::EpiRes, pg8::StaticOrder, true, true>(L + RING_OFF, g, S, E);
    }
    xcd_barrier(bar);

    {
        pg8::Gemm g{XB, Wxq_t, MTOK, DM, DM}; pg8::StaticOrder S; S.init(MTOK, DM, G, bx);
        pg8::EpiScaleBf16 E{XQ, DM, ssq1};
        pg8::gemm_phase<pg8::EpiScaleBf16, pg8::StaticOrder, true, true>(L + RING_OFF, g, S, E);
    }
    xcd_barrier(bar);

    {
        LAS float* scr = (LAS float*)(L + wave * NAIVE_WAVE_BYTES);
        for (int it = gw; it < 16 * SEQ; it += NGW) { const int bh = it >> 11, i = it & (SEQ - 1); naive_xattn_item(XQ, XKV, XO, bh >> 2, bh & 3, i, scr, lane); }
    }
    xcd_barrier(bar);

    {
        pg8::Gemm g{XO, Wxo_t, MTOK, DM, DM}; pg8::StaticOrder S; S.init(MTOK, DM, G, bx);
        pg8::EpiRes E{out, out, XB, ssq2, DM};
        pg8::gemm_phase<pg8::EpiRes, pg8::StaticOrder, true, true>(L + RING_OFF, g, S, E);
    }
    xcd_barrier(bar);

    {
        pg8::Gemm g{XB, Wgu_t, MTOK, 2 * DFF, DM}; pg8::StaticOrder S; S.init(MTOK, 2 * DFF, G, bx);
        pg8::EpiSwiGLU E{HFF, DFF, ssq2};
        pg8::gemm_phase<pg8::EpiSwiGLU, pg8::StaticOrder, true, true>(L + RING_OFF, g, S, E);
    }
    xcd_barrier(bar);

    {
        pg8::Gemm g{HFF, Wd_t, MTOK, DM, DFF}; pg8::StaticOrder S; S.init(MTOK, DM, G, bx);
        pg8::EpiRes E{out, out, nullptr, ssq3, DM};
        pg8::gemm_phase<pg8::EpiRes, pg8::StaticOrder, true, true>(L + RING_OFF, g, S, E);
    }
    xcd_barrier(bar);

    for (int m = gw; m < MTOK; m += NGW) {
        const float r = 1.0f / sqrtf(ssq3[m] * (1.0f / DM) + NORM_EPS);
        f32x4* xr = (f32x4*)(out + (size_t)m * DM) + lane; const f32x4* gr = (const f32x4*)args.in[20] + lane;
#pragma unroll
        for (int j = 0; j < 8; ++j) { const f32x4 v = xr[64 * j]; const f32x4 gg = gr[64 * j]; xr[64 * j] = v * r * gg; }
    }
}

extern "C" void kernel_launch(void* const* d_in, const int* in_sizes, int n_in, void* d_out, int out_size, void* d_ws, size_t ws_size, hipStream_t stream) {
    static int grid = 0;
    if (grid == 0) {
        if (n_in != 21 || in_sizes[0] != MTOK * DM || out_size != MTOK * DM || ws_size < WS_END) { fprintf(stderr, "kernel_launch: unexpected shapes / workspace (n_in %d, ws %zu)\n", n_in, ws_size); grid = -1; return; }
        int dev = 0, cus = 0, per_cu = 0;
        if (hipGetDevice(&dev) != hipSuccess || hipDeviceGetAttribute(&cus, hipDeviceAttributeMultiprocessorCount, dev) != hipSuccess) { grid = -1; return; }
        if (hipFuncSetAttribute((const void*)mega_fwd, hipFuncAttributeMaxDynamicSharedMemorySize, LDS_BYTES) != hipSuccess) { fprintf(stderr, "kernel_launch: hipFuncSetAttribute failed\n"); grid = -1; return; }
        if (hipOccupancyMaxActiveBlocksPerMultiprocessor(&per_cu, (const void*)mega_fwd, NWAVES * 64, LDS_BYTES) != hipSuccess || per_cu < 1) { fprintf(stderr, "kernel_launch: occupancy query reports %d blocks per CU\n", per_cu); (void)hipGetLastError(); grid = -1; return; }
        grid = cus;
    }
    if (grid < 0) return;
    if (hipMemsetAsync((char*)d_ws + WS_CTL, 0, CTL_ZERO_BYTES, stream) != hipSuccess) return;
    Args a{};
    for (int i = 0; i < 21; ++i) a.in[i] = (const float*)d_in[i];
    a.out = (float*)d_out; a.ws = (unsigned char*)d_ws;
    hipLaunchKernelGGL(mega_fwd, dim3(grid), dim3(NWAVES * 64), LDS_BYTES, stream, a);
}
```

```cpp
#include <hip/hip_runtime.h>
#include <cstdio>
#include <cstdint>
namespace pg8 {
#define PG8_LAS __attribute__((address_space(3)))
typedef unsigned short bf16_t;
typedef short bf16x8 __attribute__((ext_vector_type(8)));
typedef float f32x4 __attribute__((ext_vector_type(4)));
typedef unsigned u32x4 __attribute__((ext_vector_type(4)));
constexpr int BM = 256, BK = 64, HALF = 128, HTB = HALF * BK * 2  , STAGE_BYTES = 8 * HTB, NXCD = 8, WGM = 8;

__host__ __device__ __forceinline__ int lds_byte(int r, int c) { const int st = (r >> 4) * 2 + (c >> 5), rr = r & 15, cc = c & 31, ob = rr * 64 + cc * 2; return st * 1024 + (ob ^ (((ob >> 9) & 1) << 5)); }
__host__ __device__ __forceinline__ void stage_rc(int b, int& R, int& C) { const int st = b / 1024, sb = b % 1024, swz = sb ^ (((sb >> 9) & 1) << 5); R = (st >> 1) * 16 + swz / 64; C = (st & 1) * 32 + (swz % 64) / 2; }
__host__ __device__ __forceinline__ int perm32(int rho) { const int n = rho >> 4, i = rho & 15; return 8 * (i >> 2) + 4 * n + (i & 3); }

struct Unit { int pm, pn; };
struct Gemm { const bf16_t* A; const bf16_t* Bt; int M, N, K; };

struct StaticOrder {
    int nM, nN, nwg, G, c;
    __host__ __device__ void init(int M, int N, int G_, int c_) { nM = M / BM; nN = N / BM; nwg = nM * nN; G = G_; c = c_; }
    __host__ __device__ bool next(int i, Unit& u) const {
        const long L = (long)i * G + c; if (L >= nwg) return false;
        int wgid = (int)L; { const int q = nwg / NXCD, r = nwg % NXCD, xcd = wgid % NXCD, off = wgid / NXCD; wgid = (xcd < r ? xcd * (q + 1) : r * (q + 1) + (xcd - r) * q) + off; }
        const int nig = WGM * nN, gid = wgid / nig, fm = gid * WGM, gsz = (nM - fm) < WGM ? (nM - fm) : WGM;
        u.pm = fm + ((wgid % nig) % gsz); u.pn = (wgid % nig) / gsz; return true;
    }
    __device__ __forceinline__ void a_ready(const Unit&) const {}
    __device__ __forceinline__ void done(const Unit&) const {}
};

__device__ __forceinline__ unsigned cvt_pk_bf16(float lo, float hi) { unsigned r; asm volatile("v_cvt_pk_bf16_f32 %0, %1, %2" : "=v"(r) : "v"(lo), "v"(hi)); return r; }
typedef float f32x2 __attribute__((ext_vector_type(2)));
typedef unsigned u32x2 __attribute__((ext_vector_type(2)));
struct EpiBf16 {
    static constexpr bool PERM = true, AFTER_DRAIN = false;
    bf16_t* O; int ldc;
    __device__ __forceinline__ void operator()(const f32x4 (&acc)[2][2][4][2], const Unit& u, int wr, int wc, int fr, int fq) const {
        const int row0 = u.pm * BM + wr * 64 + fr, col0 = u.pn * BM + wc * 32 + 8 * fq;
#pragma unroll
        for (int ai = 0; ai < 2; ++ai)
#pragma unroll
            for (int m = 0; m < 4; ++m) { bf16_t* rowp = O + (size_t)(row0 + ai * HALF + m * 16) * ldc + col0;
#pragma unroll
                for (int bj = 0; bj < 2; ++bj) { const f32x4 v0 = acc[ai][bj][m][0], v1 = acc[ai][bj][m][1];
                    u32x4 w; w.x = cvt_pk_bf16(v0[0], v0[1]); w.y = cvt_pk_bf16(v0[2], v0[3]); w.z = cvt_pk_bf16(v1[0], v1[1]); w.w = cvt_pk_bf16(v1[2], v1[3]);
                    *(u32x4*)(rowp + bj * HALF) = w; } }
    }
};
struct EpiScaleBf16 {
    static constexpr bool PERM = true, AFTER_DRAIN = false;
    bf16_t* O; int ldc; const float* ssq;
    __device__ __forceinline__ void operator()(const f32x4 (&acc)[2][2][4][2], const Unit& u, int wr, int wc, int fr, int fq) const {
        const int row0 = u.pm * BM + wr * 64 + fr, col0 = u.pn * BM + wc * 32 + 8 * fq;
#pragma unroll
        for (int ai = 0; ai < 2; ++ai)
#pragma unroll
            for (int m = 0; m < 4; ++m) { const int row = row0 + ai * HALF + m * 16; bf16_t* rowp = O + (size_t)row * ldc + col0;
                const float r = 1.0f / sqrtf(ssq[row] * (1.0f / 2048.0f) + 1e-6f);
#pragma unroll
                for (int bj = 0; bj < 2; ++bj) { const f32x4 v0 = acc[ai][bj][m][0] * r, v1 = acc[ai][bj][m][1] * r;
                    u32x4 w; w.x = cvt_pk_bf16(v0[0], v0[1]); w.y = cvt_pk_bf16(v0[2], v0[3]); w.z = cvt_pk_bf16(v1[0], v1[1]); w.w = cvt_pk_bf16(v1[2], v1[3]);
                    *(u32x4*)(rowp + bj * HALF) = w; } }
    }
};
__device__ __forceinline__ float silu_f(float g) { return g * __builtin_amdgcn_rcpf(1.0f + __builtin_amdgcn_exp2f(-1.4426950408889634f * g)); }
struct EpiSwiGLU {
    static constexpr bool PERM = true, AFTER_DRAIN = false;
    bf16_t* O; int ldc; const float* ssq;
    __device__ __forceinline__ void operator()(const f32x4 (&acc)[2][2][4][2], const Unit& u, int wr, int wc, int fr, int fq) const {
        const int row0 = u.pm * BM + wr * 64 + fr, col0 = u.pn * HALF + wc * 32 + 8 * fq;
#pragma unroll
        for (int ai = 0; ai < 2; ++ai)
#pragma unroll
            for (int m = 0; m < 4; ++m) { const int row = row0 + ai * HALF + m * 16; bf16_t* rowp = O + (size_t)row * ldc + col0;
                const float r = 1.0f / sqrtf(ssq[row] * (1.0f / 2048.0f) + 1e-6f);
                float h[8];
#pragma unroll
                for (int n = 0; n < 2; ++n)
#pragma unroll
                    for (int j = 0; j < 4; ++j) { const float g = acc[ai][0][m][n][j] * r, up = acc[ai][1][m][n][j] * r; h[n * 4 + j] = silu_f(g) * up; }
                u32x4 w; w.x = cvt_pk_bf16(h[0], h[1]); w.y = cvt_pk_bf16(h[2], h[3]); w.z = cvt_pk_bf16(h[4], h[5]); w.w = cvt_pk_bf16(h[6], h[7]);
                *(u32x4*)rowp = w; }
    }
};
struct EpiRes {
    static constexpr bool PERM = false, AFTER_DRAIN = false;
    const float* base; float* out; bf16_t* xb; float* ssq; int ldc;
    __device__ __forceinline__ void operator()(const f32x4 (&acc)[2][2][4][2], const Unit& u, int wr, int wc, int fr, int fq) const {
        const int row0 = u.pm * BM + wr * 64 + fr, col0 = u.pn * BM + wc * 32 + 4 * fq;
#pragma unroll
        for (int ai = 0; ai < 2; ++ai)
#pragma unroll
            for (int m = 0; m < 4; ++m) { const int row = row0 + ai * HALF + m * 16; const size_t off = (size_t)row * ldc + col0; float s = 0.f;
#pragma unroll
                for (int bj = 0; bj < 2; ++bj)
#pragma unroll
                    for (int n = 0; n < 2; ++n) { const size_t o2 = off + bj * HALF + n * 16; const f32x4 v = *(const f32x4*)(base + o2) + acc[ai][bj][m][n];
                        *(f32x4*)(out + o2) = v; s += (v[0] * v[0] + v[1] * v[1]) + (v[2] * v[2] + v[3] * v[3]);
                        if (xb) { u32x2 w; w.x = cvt_pk_bf16(v[0], v[1]); w.y = cvt_pk_bf16(v[2], v[3]); *(u32x2*)(xb + o2) = w; } }
                s += __int_as_float(__builtin_amdgcn_ds_swizzle(__float_as_int(s), (16 << 10) | 0x1f)); { auto rr = __builtin_amdgcn_permlane32_swap(__float_as_uint(s), __float_as_uint(s), false, false); s = __uint_as_float(rr[0]) + __uint_as_float(rr[1]); }
                if (fq == 0) atomicAdd(ssq + row, s);
                if (m & 1) asm volatile("" ::: "memory"); }
    }
};
template <class Epi, class Sched, bool ALIGN_EPI = false, bool SP2 = false>
__device__ __forceinline__ void gemm_phase(PG8_LAS unsigned char* lds, const Gemm g, const Sched& S, const Epi& E, const int wave_id) {
    int lane_; asm volatile("v_mbcnt_lo_u32_b32 %0, -1, 0\n\tv_mbcnt_hi_u32_b32 %0, -1, %0" : "=v"(lane_)); const int tid_ = wave_id * 64 + lane_;
    const int tid = tid_, wid = wave_id, lane = tid & 63, wr = wid >> 2, wc = wid & 3, fr = lane & 15, fq = lane >> 4;
    const int K = g.K, nt = K / BK;
    unsigned voffA[2], voffB[2];
#pragma unroll
    for (int i = 0; i < 2; ++i) { int R, C; stage_rc(tid * 16 + i * 8192, R, C); const int Rb = Epi::PERM ? ((R & ~31) + perm32(R & 31)) : R;
        voffA[i] = (unsigned)(R * K + C) * 2u; voffB[i] = (unsigned)(Rb * K + C) * 2u; }
    const size_t kstep = (size_t)(BK * 2);
    const size_t hstep = (size_t)HALF * K * 2;
    const size_t tstep = 2 * hstep;
    const unsigned ldsw = (unsigned)wid * 1024u;
    const int aoff = lds_byte(wr * 64 + fr, fq * 8), boff = lds_byte(wc * 32 + fr, fq * 8);
#define PG8_SA(b, h) (((b) * 2 + (h)) * HTB)
#define PG8_SB(b, h) ((4 + (b) * 2 + (h)) * HTB)
#define PG8_STAGE(bufoff, gbase, voff) do { _Pragma("unroll") for (int _i = 0; _i < 2; ++_i) \
        __builtin_amdgcn_global_load_lds((const unsigned*)((const char*)(gbase) + (voff)[_i]), (PG8_LAS unsigned*)(lds + (bufoff) + ldsw + _i * 8192), 16, 0, 0); } while (0)
#define PG8_LDA(dst, b, h) do { _Pragma("unroll") for (int m = 0; m < 4; ++m) _Pragma("unroll") for (int k = 0; k < 2; ++k) dst[m][k] = *(const PG8_LAS bf16x8*)(lds + PG8_SA(b, h) + aoff + m * 2048 + k * 1024); } while (0)
#define PG8_LDB(dst, b, h) do { _Pragma("unroll") for (int n = 0; n < 2; ++n) _Pragma("unroll") for (int k = 0; k < 2; ++k) dst[n][k] = *(const PG8_LAS bf16x8*)(lds + PG8_SB(b, h) + boff + n * 2048 + k * 1024); } while (0)
#define PG8_MMA(ai, bj, At, Bt) do { __builtin_amdgcn_s_setprio(1); _Pragma("unroll") for (int m = 0; m < 4; ++m) _Pragma("unroll") for (int n = 0; n < 2; ++n) _Pragma("unroll") for (int k = 0; k < 2; ++k) \
        acc[ai][bj][m][n] = __builtin_amdgcn_mfma_f32_16x16x32_bf16(Bt[n][k], At[m][k], acc[ai][bj][m][n], 0, 0, 0); __builtin_amdgcn_s_setprio(0); } while (0)
#define PG8_WAIT_V(n) asm volatile("s_waitcnt vmcnt(" #n ")" ::: "memory")
#define PG8_WAIT_L(n) asm volatile("s_waitcnt lgkmcnt(" #n ")" ::: "memory")
#define PG8_BAR __builtin_amdgcn_s_barrier()
#define PG8_SCHED __builtin_amdgcn_sched_barrier(0)
    Unit cur, nxt; int ui = 0;
    if (!S.next(0, cur)) return;
    f32x4 acc[2][2][4][2];
#pragma unroll
    for (int a = 0; a < 2; ++a)
#pragma unroll
        for (int b = 0; b < 2; ++b)
#pragma unroll
            for (int m = 0; m < 4; ++m)
#pragma unroll
                for (int n = 0; n < 2; ++n) acc[a][b][m][n] = (f32x4){0.f, 0.f, 0.f, 0.f};
    bf16x8 At[4][2], B0[2][2], B1[2][2];
    const char* cA = (const char*)g.A + (size_t)cur.pm * tstep; const char* cB = (const char*)g.Bt + (size_t)cur.pn * tstep;
    S.a_ready(cur);
    if constexpr (SP2) {
        PG8_STAGE(PG8_SB(0, 0), cB, voffB); PG8_STAGE(PG8_SB(0, 1), cB + hstep, voffB); PG8_STAGE(PG8_SA(0, 0), cA, voffA); PG8_STAGE(PG8_SA(0, 1), cA + hstep, voffA);
        if (wr == 1) PG8_BAR;
        PG8_WAIT_V(2); PG8_BAR;
        PG8_STAGE(PG8_SB(1, 0), cB + kstep, voffB); PG8_STAGE(PG8_SA(1, 0), cA + kstep, voffA); PG8_STAGE(PG8_SB(1, 1), cB + hstep + kstep, voffB);
        PG8_WAIT_V(6); PG8_BAR;
    } else {
        PG8_STAGE(PG8_SB(0, 0), cB, voffB); PG8_STAGE(PG8_SA(0, 0), cA, voffA); PG8_STAGE(PG8_SB(0, 1), cB + hstep, voffB); PG8_STAGE(PG8_SA(0, 1), cA + hstep, voffA);
        if (wr == 1) PG8_BAR;
        PG8_WAIT_V(4); PG8_BAR;
        PG8_STAGE(PG8_SB(1, 0), cB + kstep, voffB); PG8_STAGE(PG8_SA(1, 0), cA + kstep, voffA); PG8_STAGE(PG8_SB(1, 1), cB + hstep + kstep, voffB);
        PG8_WAIT_V(6); PG8_BAR;
    }
    for (;;) {
        const bool has_next = S.next(ui + 1, nxt);
        const char* nA = has_next ? (const char*)g.A + (size_t)nxt.pm * tstep : cA; const char* nB = has_next ? (const char*)g.Bt + (size_t)nxt.pn * tstep : cB;
        for (int t = 0; t < nt; t += 2) {
            const bool last = (t == nt - 2);
            const char* a1 = cA + (size_t)(t + 1) * kstep;
            const char* a2 = last ? nA : cA + (size_t)(t + 2) * kstep; const char* b2 = last ? nB : cB + (size_t)(t + 2) * kstep;
            const char* a3 = a2 + kstep; const char* b3 = b2 + kstep;
            if (last && has_next) S.a_ready(nxt);
            if constexpr (SP2) {
            PG8_LDB(B0, 0, 0); PG8_LDB(B1, 0, 1); PG8_SCHED; PG8_LDA(At, 0, 0); PG8_STAGE(PG8_SA(1, 1), a1 + hstep, voffA);
            PG8_WAIT_V(8); PG8_WAIT_L(0); PG8_BAR; PG8_MMA(0, 0, At, B0); PG8_MMA(0, 1, At, B1); PG8_BAR; PG8_SCHED;
            PG8_LDA(At, 0, 1); PG8_STAGE(PG8_SB(0, 0), b2, voffB); PG8_STAGE(PG8_SB(0, 1), b2 + hstep, voffB); PG8_STAGE(PG8_SA(0, 0), a2, voffA);
            PG8_WAIT_V(8); PG8_WAIT_L(0); PG8_BAR; PG8_MMA(1, 0, At, B0); PG8_MMA(1, 1, At, B1); PG8_BAR; PG8_SCHED;
            PG8_LDB(B0, 1, 0); PG8_LDB(B1, 1, 1); PG8_SCHED; PG8_LDA(At, 1, 0); PG8_STAGE(PG8_SA(0, 1), a2 + hstep, voffA);
            PG8_WAIT_V(8); PG8_WAIT_L(0); PG8_BAR; PG8_MMA(0, 0, At, B0); PG8_MMA(0, 1, At, B1); PG8_BAR; PG8_SCHED;
            PG8_LDA(At, 1, 1); PG8_STAGE(PG8_SB(1, 0), b3, voffB); PG8_STAGE(PG8_SB(1, 1), b3 + hstep, voffB); PG8_STAGE(PG8_SA(1, 0), a3, voffA);
            PG8_WAIT_V(8); PG8_WAIT_L(0); PG8_BAR; PG8_MMA(1, 0, At, B0); PG8_MMA(1, 1, At, B1); PG8_BAR; PG8_SCHED;
            } else {
            PG8_LDB(B0, 0, 0); PG8_SCHED; PG8_LDA(At, 0, 0); PG8_STAGE(PG8_SA(1, 1), a1 + hstep, voffA);
            PG8_WAIT_L(8); PG8_BAR; PG8_WAIT_L(0); PG8_MMA(0, 0, At, B0); PG8_BAR; PG8_SCHED;
            PG8_LDB(B1, 0, 1); PG8_STAGE(PG8_SB(0, 0), b2, voffB);
            PG8_BAR; PG8_WAIT_L(0); PG8_MMA(0, 1, At, B1); PG8_BAR;
            PG8_LDA(At, 0, 1); PG8_STAGE(PG8_SA(0, 0), a2, voffA);
            PG8_BAR; PG8_WAIT_L(0); PG8_MMA(1, 0, At, B0); PG8_BAR; PG8_SCHED;
            PG8_STAGE(PG8_SB(0, 1), b2 + hstep, voffB);
            PG8_WAIT_V(6); PG8_BAR; PG8_MMA(1, 1, At, B1); PG8_BAR;
            PG8_LDB(B0, 1, 0); PG8_SCHED; PG8_LDA(At, 1, 0); PG8_STAGE(PG8_SA(0, 1), a2 + hstep, voffA);
            PG8_WAIT_L(8); PG8_BAR; PG8_WAIT_L(0); PG8_MMA(0, 0, At, B0); PG8_BAR; PG8_SCHED;
            PG8_LDB(B1, 1, 1); PG8_STAGE(PG8_SB(1, 0), b3, voffB);
            PG8_BAR; PG8_WAIT_L(0); PG8_MMA(0, 1, At, B1); PG8_BAR;
            PG8_LDA(At, 1, 1); PG8_STAGE(PG8_SA(1, 0), a3, voffA);
            PG8_BAR; PG8_WAIT_L(0); PG8_MMA(1, 0, At, B0); PG8_BAR; PG8_SCHED;
            PG8_STAGE(PG8_SB(1, 1), b3 + hstep, voffB);
            PG8_WAIT_V(6); PG8_BAR; PG8_MMA(1, 1, At, B1); PG8_BAR;
            }
        }
        if constexpr (ALIGN_EPI) { if (wr == 0) PG8_BAR; }
        if constexpr (!Epi::AFTER_DRAIN) { int l2_; asm volatile("v_mbcnt_lo_u32_b32 %0, -1, 0\n\tv_mbcnt_hi_u32_b32 %0, -1, %0" : "=v"(l2_)); E(acc, cur, wr, wc, l2_ & 15, l2_ >> 4); S.done(cur); }
        if (!has_next) break;
#pragma unroll
        for (int a = 0; a < 2; ++a)
#pragma unroll
            for (int b = 0; b < 2; ++b)
#pragma unroll
                for (int m = 0; m < 4; ++m)
#pragma unroll
                    for (int n = 0; n < 2; ++n) acc[a][b][m][n] = (f32x4){0.f, 0.f, 0.f, 0.f};
        cur = nxt; cA = nA; cB = nB; ++ui;
        if constexpr (ALIGN_EPI) { if (wr == 1) PG8_BAR; }
    }
    PG8_WAIT_V(0);
    if constexpr (!ALIGN_EPI) { if (wr == 0) PG8_BAR; }
    PG8_BAR;
    if constexpr (Epi::AFTER_DRAIN) { E.fused(acc, cur, wr, wc, fr, fq, lds, wid, lane); S.done(cur); }
#undef PG8_SA
#undef PG8_SB
#undef PG8_STAGE
#undef PG8_LDA
#undef PG8_LDB
#undef PG8_MMA
#undef PG8_WAIT_V
#undef PG8_WAIT_L
#undef PG8_BAR
#undef PG8_SCHED
}
}

constexpr int NWAVES = 8;
constexpr int BATCH = 4, SEQ = 2048, DM = 2048, MTOK = BATCH * SEQ, MEMLEN = 256, MMEM = BATCH * MEMLEN, INC = 6144, DFF = 5632;
constexpr float NORM_EPS = 1e-6f;
constexpr size_t MiB = 1u << 20;
constexpr size_t WS_CTL = 0, CTL_ZERO_BYTES = 64 * 1024;
constexpr size_t WS_SSQ = 1 * MiB;
constexpr size_t WS_WIN = 2 * MiB, WS_WO = 26 * MiB, WS_WXQ = 34 * MiB, WS_WXKV = 42 * MiB, WS_WXO = 58 * MiB, WS_WGU = 66 * MiB, WS_WD = 110 * MiB;
constexpr size_t WS_HM = 132 * MiB, WS_XKV = 136 * MiB;
constexpr size_t WS_B = 144 * MiB;
constexpr size_t WS_C = 176 * MiB;
constexpr size_t WS_A = 208 * MiB;
constexpr size_t WS_END = 304 * MiB;
constexpr int CW_BAR = 4096, CW_Q = 8192;
constexpr int RING_OFF = 0, RING_BYTES = 131072;
constexpr int NAIVE_WAVE_BYTES = 17408;
constexpr int LDSCTL_OFF = 143360, MISC_OFF = LDSCTL_OFF + 320;
constexpr int LDS_BYTES = 147456;
static_assert(NWAVES * NAIVE_WAVE_BYTES <= LDSCTL_OFF && MISC_OFF + 128 <= LDS_BYTES, "LDS map");

#define GAS __attribute__((address_space(1)))
#define LAS __attribute__((address_space(3)))
typedef unsigned short bf16;
typedef unsigned v4u __attribute__((ext_vector_type(4)));
typedef unsigned v2u __attribute__((ext_vector_type(2)));
typedef float f32x4 __attribute__((ext_vector_type(4)));
typedef GAS unsigned gu32;
#define RLX_AGENT __ATOMIC_RELAXED, __HIP_MEMORY_SCOPE_AGENT
#define LDS_WAIT() asm volatile("s_waitcnt lgkmcnt(0)" ::: "memory")
#define VM_WAIT() asm volatile("s_waitcnt vmcnt(0)" ::: "memory")
__device__ __forceinline__ unsigned f2bf(float f) { unsigned u = __builtin_bit_cast(unsigned, f); return (u + 0x7fffu + ((u >> 16) & 1u)) >> 16; }
__device__ __forceinline__ unsigned pk2(float lo, float hi) { return f2bf(lo) | (f2bf(hi) << 16); }
__device__ __forceinline__ float bflo(unsigned w) { return __uint_as_float(w << 16); }
__device__ __forceinline__ float bfhi(unsigned w) { return __uint_as_float(w & 0xffff0000u); }
__device__ __forceinline__ float bf2f(bf16 v) { return __uint_as_float(((unsigned)v) << 16); }

#define XB_TMO      128
#define XB_XCNT(j)  (256  + 64 * (j))
#define XB_XSUB(j)  (1280 + 64 * (j))
#define XB_XGEN(j)  (2304 + 64 * (j))
#define XB_TOP      3328
#define XB_TOPGEN   3392
#define XCD_BAR_WORDS 3456
#define XB_SPIN_CAP (1u << 22)
__device__ __forceinline__ unsigned xb_ld(unsigned* p)              { return __hip_atomic_load(p, __ATOMIC_RELAXED, __HIP_MEMORY_SCOPE_AGENT); }
__device__ __forceinline__ unsigned xb_add(unsigned* p, unsigned v) { return __hip_atomic_fetch_add(p, v, __ATOMIC_RELAXED, __HIP_MEMORY_SCOPE_AGENT); }
__device__ __forceinline__ unsigned xb_xcc_id() { return (unsigned)__builtin_amdgcn_s_getreg((3 << 11) | 20) & 0xFu; }
#define XB_SPIN(cond, bar) do { unsigned _sp = 0; while (cond) { __builtin_amdgcn_s_sleep(1); \
    if ((++_sp & 255u) == 0u) { if (xb_ld(&(bar)[XB_TMO])) break; if (_sp > XB_SPIN_CAP) { atomicAdd(&(bar)[XB_TMO], 1u); break; } } } } while (0)
struct XcdBarrier { unsigned* bar; unsigned x; volatile LAS unsigned* st; };
__device__ __forceinline__ XcdBarrier xcd_barrier_post(unsigned* bar, volatile LAS unsigned* st) {
    XcdBarrier b; b.bar = bar; b.x = xb_xcc_id(); b.st = st;
    if (threadIdx.x == 0) (void)xb_add(&bar[XB_XCNT(b.x)], 1u);
    return b;
}
__device__ __forceinline__ void xcd_barrier_complete(unsigned* bar, unsigned x, unsigned& nloc, unsigned& nx) {
    const unsigned G = gridDim.x * gridDim.y * gridDim.z;
    unsigned sum, cnt, mine, sp = 0u;
    for (;;) {
        sum = 0u; cnt = 0u; mine = 0u;
#pragma unroll
        for (unsigned j = 0; j < 16; ++j) { const unsigned c = xb_ld(&bar[XB_XCNT(j)]); sum += c; cnt += (c > 0u) ? 1u : 0u; mine = (j == x) ? c : mine; }
        if (sum == G) break;
        __builtin_amdgcn_s_sleep(1);
        if ((++sp & 255u) == 0u) { if (xb_ld(&bar[XB_TMO])) break; if (sp > XB_SPIN_CAP) { atomicAdd(&bar[XB_TMO], 1u); break; } }
    }
    nloc = mine > 0u ? mine : 1u; nx = cnt > 0u ? cnt : 1u;
}
__device__ __forceinline__ void xcd_barrier(const XcdBarrier& b) {
    asm volatile("s_waitcnt vmcnt(0)" ::: "memory");
    __syncthreads();
    if (threadIdx.x == 0) {
        unsigned* bar = b.bar;
        __builtin_amdgcn_s_waitcnt(0);
        unsigned nloc = b.st[0], nx = b.st[1];
        if (nloc == 0u) { xcd_barrier_complete(bar, b.x, nloc, nx); b.st[0] = nloc; b.st[1] = nx; }
        const unsigned old = xb_add(&bar[XB_XSUB(b.x)], 1u);
        const unsigned gen = old / nloc;
        if (old + 1u == (gen + 1u) * nloc) {
            __builtin_amdgcn_fence(__ATOMIC_RELEASE, "agent");
            asm volatile("s_waitcnt vmcnt(0)" ::: "memory");
            const unsigned og = xb_add(&bar[XB_TOP], 1u);
            const unsigned tg = og / nx;
            if (og + 1u == (tg + 1u) * nx) xb_add(&bar[XB_TOPGEN], 1u);
            else XB_SPIN(xb_ld(&bar[XB_TOPGEN]) == tg, bar);
            __builtin_amdgcn_fence(__ATOMIC_ACQUIRE, "agent");
            xb_add(&bar[XB_XGEN(b.x)], 1u);
            asm volatile("s_waitcnt vmcnt(0)" ::: "memory");
        } else {
            XB_SPIN(xb_ld(&bar[XB_XGEN(b.x)]) == gen, bar);
            __builtin_amdgcn_fence(__ATOMIC_ACQUIRE, "agent");
            asm volatile("s_waitcnt vmcnt(0)" ::: "memory");
        }
    }
    __syncthreads();
}

__device__ __forceinline__ int lane_id_fresh() { int l; asm volatile("v_mbcnt_lo_u32_b32 %0, -1, 0\n\tv_mbcnt_hi_u32_b32 %0, -1, %0" : "=v"(l)); return l; }
template <int X> __device__ __forceinline__ float swz_xor(float v) { return __int_as_float(__builtin_amdgcn_ds_swizzle(__float_as_int(v), (X << 10) | 0x1f)); }
__device__ __forceinline__ float wave_sum(float v) {
    v += swz_xor<1>(v); v += swz_xor<2>(v); v += swz_xor<4>(v); v += swz_xor<8>(v); v += swz_xor<16>(v);
    auto rr = __builtin_amdgcn_permlane32_swap(__float_as_uint(v), __float_as_uint(v), false, false); return __uint_as_float(rr[0]) + __uint_as_float(rr[1]);
}
__device__ __forceinline__ float wave_max(float v) {
    v = fmaxf(v, swz_xor<1>(v)); v = fmaxf(v, swz_xor<2>(v)); v = fmaxf(v, swz_xor<4>(v)); v = fmaxf(v, swz_xor<8>(v)); v = fmaxf(v, swz_xor<16>(v));
    auto rr = __builtin_amdgcn_permlane32_swap(__float_as_uint(v), __float_as_uint(v), false, false); return fmaxf(__uint_as_float(rr[0]), __uint_as_float(rr[1]));
}

__device__ __forceinline__ void p0_transpose_item(const float* W, int K, int N, bf16* WT, int mode, int row_off, const float* gain, LAS float* scr, int item, int lane) {
    const int nblk = N / 32, kb = item / nblk, nb = item % nblk, k0 = 64 * kb, n0 = 32 * nb;
#pragma unroll 8
    for (int i = 0; i < 32; ++i) { const int kk = 2 * i + (lane >> 5); float w = W[(size_t)(k0 + kk) * N + n0 + (lane & 31)]; if (gain) w *= gain[k0 + kk]; scr[kk * 33 + (lane & 31)] = w; }
    LDS_WAIT(); asm volatile("" ::: "memory");
    const int c = lane & 7;
    const int r0 = (mode == 0) ? (row_off + n0) : (256 * (n0 >> 7) + 128 * (mode - 1) + (n0 & 127));
#pragma unroll
    for (int j = 0; j < 4; ++j) { const int n = (lane >> 3) + 8 * j; const LAS float* s = scr + (8 * c) * 33 + n;
        v4u o; o.x = pk2(s[0 * 33], s[1 * 33]); o.y = pk2(s[2 * 33], s[3 * 33]); o.z = pk2(s[4 * 33], s[5 * 33]); o.w = pk2(s[6 * 33], s[7 * 33]);
        *(v4u*)(WT + (size_t)(r0 + n) * K + k0 + 8 * c) = o; }
    LDS_WAIT(); asm volatile("" ::: "memory");
}
__device__ __forceinline__ void rms_row_to_bf16(const float* xrow, const float* g, bf16* orow, int lane) {
    const f32x4* xr = (const f32x4*)xrow + lane; const f32x4* gr = (const f32x4*)g + lane;
    f32x4 v[8]; float s = 0.f;
#pragma unroll
    for (int j = 0; j < 8; ++j) { v[j] = xr[64 * j]; s += (v[j].x * v[j].x + v[j].y * v[j].y) + (v[j].z * v[j].z + v[j].w * v[j].w); }
    const float r = 1.0f / sqrtf(wave_sum(s) * (1.f / DM) + NORM_EPS);
    v2u* o8 = (v2u*)orow + lane;
#pragma unroll
    for (int j = 0; j < 8; ++j) { const f32x4 gg = gr[64 * j]; v2u w; w.x = pk2(v[j].x * r * gg.x, v[j].y * r * gg.y); w.y = pk2(v[j].z * r * gg.z, v[j].w * r * gg.w); o8[64 * j] = w; }
}

__device__ __forceinline__ float dot_lds_bf16(const LAS float* q, const bf16* k, int n) {
    float s = 0.f;
    for (int d = 0; d < n; d += 8) { const v4u w = *(const v4u*)(k + d);
        s += q[d] * bflo(w.x) + q[d + 1] * bfhi(w.x) + q[d + 2] * bflo(w.y) + q[d + 3] * bfhi(w.y) + q[d + 4] * bflo(w.z) + q[d + 5] * bfhi(w.z) + q[d + 6] * bflo(w.w) + q[d + 7] * bfhi(w.w); }
    return s;
}
__device__ __forceinline__ void naive_da_item(const bf16* P, bf16* MIX, const float* subg, float lam, int b, int h, int i, LAS float* scr, int lane) {
    const size_t rowq = (size_t)(b * SEQ + i) * INC;
    LAS float* qs = scr; LAS float* tmp = scr + 256; LAS float* as = scr + 256 + 2048;
    for (int t = lane; t < 256; t += 64) qs[t] = bf2f(P[rowq + h * 256 + t]);
    LDS_WAIT(); asm volatile("" ::: "memory");
    const float slope = exp2f(-2.0f * (float)(h + 1)), scale = 0.08838834764831845f;
    for (int c = 0; c < 2; ++c) {
        float mx = -3.0e38f;
        for (int j = lane; j <= i; j += 64) {
            const bf16* kr = P + (size_t)(b * SEQ + j) * INC + 1024 + h * 256 + c * 128;
            float s = dot_lds_bf16(qs + c * 128, kr, 128);
            s = s * scale - slope * (float)(i - j);
            tmp[j] = s; mx = fmaxf(mx, s);
        }
        mx = wave_max(mx);
        float sum = 0.f;
        for (int j = lane; j <= i; j += 64) { const float p = __expf(tmp[j] - mx); tmp[j] = p; sum += p; }
        sum = wave_sum(sum);
        const float inv = 1.0f / sum;
        for (int j = lane; j <= i; j += 64) { if (c == 0) as[j] = tmp[j] * inv; else as[j] -= lam * tmp[j] * inv; }
    }
    LDS_WAIT(); asm volatile("" ::: "memory");
    float o0 = 0.f, o1 = 0.f, o2 = 0.f, o3 = 0.f;
    const bf16* vb = P + (size_t)(b * SEQ) * INC + 2048 + h * 256 + 4 * lane;
    for (int j = 0; j <= i; ++j) { const float a = as[j]; const v2u w = *(const v2u*)(vb + (size_t)j * INC);
        o0 += a * bflo(w.x); o1 += a * bfhi(w.x); o2 += a * bflo(w.y); o3 += a * bfhi(w.y); }
    const float ss = wave_sum(o0 * o0 + o1 * o1 + o2 * o2 + o3 * o3);
    const float r = 0.8f / sqrtf(ss * (1.0f / 256.0f) + NORM_EPS);
    const f32x4 g = *(const f32x4*)(subg + 4 * lane);
    v2u w; w.x = pk2(o0 * r * g.x, o1 * r * g.y); w.y = pk2(o2 * r * g.z, o3 * r * g.w);
    *(v2u*)(MIX + (size_t)(b * SEQ + i) * DM + h * 256 + 4 * lane) = w;
    LDS_WAIT(); asm volatile("" ::: "memory");
}
__device__ __forceinline__ void naive_ret_item(const bf16* P, bf16* MIX, int b, int h, int i, LAS float* scr, int lane) {
    const size_t rowq = (size_t)(b * SEQ + i) * INC;
    LAS float* qs = scr; LAS float* as = scr + 256;
    for (int t = lane; t < 128; t += 64) qs[t] = bf2f(P[rowq + 3072 + h * 128 + t]);
    LDS_WAIT(); asm volatile("" ::: "memory");
    const float lg = logf(1.0f - exp2f(-5.0f - (float)h)), scale = 0.08838834764831845f;
    for (int j = lane; j <= i; j += 64) {
        const bf16* kr = P + (size_t)(b * SEQ + j) * INC + 3584 + h * 128;
        const float s = dot_lds_bf16(qs, kr, 128);
        as[j] = s * scale * __expf(lg * (float)(i - j));
    }
    LDS_WAIT(); asm volatile("" ::: "memory");
    float o0 = 0.f, o1 = 0.f, o2 = 0.f, o3 = 0.f;
    const bf16* vb = P + (size_t)(b * SEQ) * INC + 4096 + h * 256 + 4 * lane;
    for (int j = 0; j <= i; ++j) { const float a = as[j]; const v2u w = *(const v2u*)(vb + (size_t)j * INC);
        o0 += a * bflo(w.x); o1 += a * bfhi(w.x); o2 += a * bflo(w.y); o3 += a * bfhi(w.y); }
    const float ss = wave_sum(o0 * o0 + o1 * o1 + o2 * o2 + o3 * o3);
    const float r = 1.0f / sqrtf(ss * (1.0f / 256.0f) + NORM_EPS);
    const v2u gw = *(const v2u*)(P + rowq + 5120 + h * 256 + 4 * lane);
    const float g0 = bflo(gw.x), g1 = bfhi(gw.x), g2 = bflo(gw.y), g3 = bfhi(gw.y);
    v2u w; w.x = pk2(o0 * r * (g0 / (1.0f + __expf(-g0))), o1 * r * (g1 / (1.0f + __expf(-g1)))); w.y = pk2(o2 * r * (g2 / (1.0f + __expf(-g2))), o3 * r * (g3 / (1.0f + __expf(-g3))));
    *(v2u*)(MIX + (size_t)(b * SEQ + i) * DM + 1024 + h * 256 + 4 * lane) = w;
    LDS_WAIT(); asm volatile("" ::: "memory");
}
__device__ __forceinline__ void naive_xattn_item(const bf16* XQ, const bf16* XKV, bf16* XO, int b, int h, int i, LAS float* scr, int lane) {
    const size_t rowq = (size_t)(b * SEQ + i) * DM + h * 512;
    LAS float* qs = scr; LAS float* as = scr + 512;
    for (int t = lane; t < 512; t += 64) qs[t] = bf2f(XQ[rowq + t]);
    LDS_WAIT(); asm volatile("" ::: "memory");
    const float scale = 0.044194173824159216f;
    float sc[4]; float mx = -3.0e38f;
#pragma unroll
    for (int t = 0; t < 4; ++t) { const int j = lane + 64 * t; sc[t] = dot_lds_bf16(qs, XKV + (size_t)(b * MEMLEN + j) * 4096 + h * 512, 512) * scale; mx = fmaxf(mx, sc[t]); }
    mx = wave_max(mx);
    float sum = 0.f;
#pragma unroll
    for (int t = 0; t < 4; ++t) { sc[t] = __expf(sc[t] - mx); sum += sc[t]; }
    sum = wave_sum(sum);
    const float inv = 1.0f / sum;
#pragma unroll
    for (int t = 0; t < 4; ++t) as[lane + 64 * t] = sc[t] * inv;
    LDS_WAIT(); asm volatile("" ::: "memory");
    float o[8];
#pragma unroll
    for (int e = 0; e < 8; ++e) o[e] = 0.f;
    const bf16* vb = XKV + (size_t)(b * MEMLEN) * 4096 + 2048 + h * 512 + 8 * lane;
    for (int j = 0; j < MEMLEN; ++j) { const float a = as[j]; const v4u w = *(const v4u*)(vb + (size_t)j * 4096);
        o[0] += a * bflo(w.x); o[1] += a * bfhi(w.x); o[2] += a * bflo(w.y); o[3] += a * bfhi(w.y); o[4] += a * bflo(w.z); o[5] += a * bfhi(w.z); o[6] += a * bflo(w.w); o[7] += a * bfhi(w.w); }
    v4u w; w.x = pk2(o[0], o[1]); w.y = pk2(o[2], o[3]); w.z = pk2(o[4], o[5]); w.w = pk2(o[6], o[7]);
    *(v4u*)(XO + rowq + 8 * lane) = w;
    LDS_WAIT(); asm volatile("" ::: "memory");
}


namespace att {
typedef short bf16x8 __attribute__((ext_vector_type(8)));
typedef short s16x4 __attribute__((ext_vector_type(4)));
typedef float f32x16 __attribute__((ext_vector_type(16)));
typedef unsigned u32x4 __attribute__((ext_vector_type(4)));
#define ATT_SBAR() __builtin_amdgcn_sched_barrier(0)
__device__ __forceinline__ int crow(int r, int hi) { return (r & 3) + 8 * (r >> 2) + 4 * hi; }
__device__ __forceinline__ unsigned cvtpk(float lo, float hi) { unsigned r; asm volatile("v_cvt_pk_bf16_f32 %0, %1, %2" : "=v"(r) : "v"(lo), "v"(hi)); return r; }
#define ATT_KSWZ(row, colB) ((row) * 256 + ((colB) ^ (((row) & 7) << 4)))
__device__ __forceinline__ int v_rd_base(int lane) { return ((lane & 3) << 3) | (((lane >> 2) & 3) << 6) | (((lane >> 4) & 1) << 5) | (((lane >> 5) & 1) << 8); }
__device__ __forceinline__ s16x4 vtr(const LAS unsigned char* p) { return __builtin_bit_cast(s16x4, __builtin_amdgcn_ds_read_tr16_b64_v4i16((LAS s16x4*)p)); }
#define ATT_PK4(P, BASE, OUT) do { unsigned a0_ = att::cvtpk(P[BASE + 0], P[BASE + 1]), a1_ = att::cvtpk(P[BASE + 2], P[BASE + 3]);   \
    unsigned b0_ = att::cvtpk(P[BASE + 4], P[BASE + 5]), b1_ = att::cvtpk(P[BASE + 6], P[BASE + 7]);                              \
    auto r0_ = __builtin_amdgcn_permlane32_swap(a0_, b0_, false, false); auto r1_ = __builtin_amdgcn_permlane32_swap(a1_, b1_, false, false); \
    att::u32x4 w_ = {r0_[0], r1_[0], r0_[1], r1_[1]}; OUT = __builtin_bit_cast(att::bf16x8, w_); } while (0)
__device__ __forceinline__ void glds16(const void* gsrc, LAS unsigned char* lds_dst) { __builtin_amdgcn_global_load_lds((const unsigned*)gsrc, (LAS unsigned*)lds_dst, 16, 0, 0); }
__device__ __forceinline__ void k_src(int n, int L, int& row, int& chunk) { row = 4 * n + (L >> 4); chunk = (L & 15) ^ (row & 7); }
template <int NCB> __device__ __forceinline__ void v_src(int n, int L, int& key, int& col) {
    const int off = n * 1024 + 16 * L, s = off >> 9, within = off & 511, kk7 = within >> 6, col8 = (within & 63) >> 1;
    const int kk = ((s / NCB) << 3) | kk7; key = (kk & ~0xC) | ((kk & 4) << 1) | ((kk & 8) >> 1); col = (s % NCB) * 32 + col8;
}
__device__ __forceinline__ float halfmax(float m) { auto rr = __builtin_amdgcn_permlane32_swap(__float_as_uint(m), __float_as_uint(m), false, false); return fmaxf(__uint_as_float(rr[0]), __uint_as_float(rr[1])); }
__device__ __forceinline__ float halfsum(float m) { auto rr = __builtin_amdgcn_permlane32_swap(__float_as_uint(m), __float_as_uint(m), false, false); return __uint_as_float(rr[0]) + __uint_as_float(rr[1]); }

__device__ __forceinline__ void stage_voffs(int lane, unsigned pitch, unsigned& vk0, unsigned& vk1, unsigned& vv) {
    vk0 = (unsigned)(lane >> 4) * pitch + (unsigned)(((lane & 15) ^ ((lane >> 4) & 7)) * 16);
    vk1 = (unsigned)(lane >> 4) * pitch + (unsigned)(((lane & 15) ^ ((4 + (lane >> 4)) & 7)) * 16);
    vv = (unsigned)(((lane >> 4) & 1) * 8 + ((lane >> 2) & 3)) * pitch + (unsigned)(((lane >> 5) * 32 + 8 * (lane & 3)) * 2);
}
__device__ __forceinline__ void xattn_stage(LAS unsigned char* buf, const bf16* XKV, int b, int h, int c, int wid, unsigned vk0, unsigned vk1, unsigned vv) {
    const char* base = (const char*)(XKV + (size_t)(b * MEMLEN) * 4096 + h * 512);
    if (c < 4) {
#pragma unroll
        for (int t = 0; t < 8; ++t) glds16(base + (size_t)((32 * wid + 4 * t) * 8192 + c * 256) + ((t & 1) ? vk1 : vk0), buf + (wid * 8 + t) * 1024);
    } else {
#pragma unroll
        for (int t = 0; t < 8; ++t) glds16(base + (size_t)((32 * wid + 16 * (t >> 2) + 4 * ((t >> 1) & 1)) * 8192 + (2048 + (c - 4) * 128 + 64 * (t & 1)) * 2) + vv, buf + (wid * 8 + t) * 1024);
    }
}
__device__ __forceinline__ void xattn_unit(LAS unsigned char* L, const bf16* XQ, const bf16* XKV, bf16* XO, int b, int h, int qb, const int wid) {
    const int lane = lane_id_fresh();
    const int r32 = lane & 31, hi = lane >> 5;
    const size_t row0 = (size_t)(b * SEQ + qb * 256 + wid * 32);
    const bf16* Qw = XQ + (row0 + r32) * DM + h * 512 + hi * 8;
    f32x16 p[8];
#pragma unroll
    for (int kb = 0; kb < 8; ++kb) p[kb] = f32x16{};
    bf16x8 qc[8];
#pragma unroll
    for (int d0 = 0; d0 < 8; ++d0) qc[d0] = *(const bf16x8*)(Qw + d0 * 16);
    unsigned vk0, vk1, vv; stage_voffs(lane, 8192u, vk0, vk1, vv);
    xattn_stage(L, XKV, b, h, 0, wid, vk0, vk1, vv);
    asm volatile("s_waitcnt vmcnt(0)" ::: "memory"); __syncthreads();
#pragma unroll 1
    for (int c = 0; c < 4; ++c) {
        LAS unsigned char* cur = L + (c & 1) * 65536; LAS unsigned char* nxt = L + ((c + 1) & 1) * 65536;
        xattn_stage(nxt, XKV, b, h, c + 1, wid, vk0, vk1, vv);
#pragma unroll
        for (int kb = 0; kb < 8; ++kb)
#pragma unroll
            for (int d0 = 0; d0 < 8; ++d0) { const int cb = (d0 * 16 + hi * 8) * 2;
                const bf16x8 kf = *(const LAS bf16x8*)(cur + ATT_KSWZ(kb * 32 + r32, cb));
                p[kb] = __builtin_amdgcn_mfma_f32_32x32x16_bf16(kf, qc[d0], p[kb], 0, 0, 0); }
        if (c < 3) {
#pragma unroll
            for (int d0 = 0; d0 < 8; ++d0) qc[d0] = *(const bf16x8*)(Qw + (c + 1) * 128 + d0 * 16);
        }
        asm volatile("s_waitcnt vmcnt(0)" ::: "memory"); __syncthreads();
    }
    constexpr float C = 0.044194173824159216f * 1.4426950408889634f;
    float mx = -3.0e38f;
#pragma unroll
    for (int kb = 0; kb < 8; ++kb)
#pragma unroll
        for (int r = 0; r < 16; ++r) mx = fmaxf(mx, p[kb][r]);
    mx = halfmax(mx);
    const float mC = -mx * C; float sum = 0.f;
#pragma unroll
    for (int kb = 0; kb < 8; ++kb)
#pragma unroll
        for (int r = 0; r < 16; ++r) { p[kb][r] = __builtin_amdgcn_exp2f(fmaf(p[kb][r], C, mC)); sum += p[kb][r]; }
    sum = halfsum(sum);
    const float inv = 1.0f / sum;
    bf16x8 pa[16];
#pragma unroll
    for (int kb = 0; kb < 8; ++kb) {
#pragma unroll
        for (int r = 0; r < 16; ++r) p[kb][r] *= inv;
        ATT_PK4(p[kb], 0, pa[2 * kb]); ATT_PK4(p[kb], 8, pa[2 * kb + 1]);
    }
    const int vb = v_rd_base(lane);
#pragma unroll 1
    for (int c = 4; c < 8; ++c) {
        LAS unsigned char* cur = L + (c & 1) * 65536; LAS unsigned char* nxt = L + ((c + 1) & 1) * 65536;
        if (c < 7) xattn_stage(nxt, XKV, b, h, c + 1, wid, vk0, vk1, vv);
        f32x16 o[4];
#pragma unroll
        for (int d0 = 0; d0 < 4; ++d0) { o[d0] = f32x16{};
#pragma unroll
            for (int ks = 0; ks < 16; ++ks) {
                const s16x4 lo = vtr(cur + vb + d0 * 512 + ks * 4096), hh = vtr(cur + vb + d0 * 512 + ks * 4096 + 2048);
                const bf16x8 vf = {lo[0], lo[1], lo[2], lo[3], hh[0], hh[1], hh[2], hh[3]};
                o[d0] = __builtin_amdgcn_mfma_f32_32x32x16_bf16(pa[ks], vf, o[d0], 0, 0, 0); } }
        bf16* Ow = XO + row0 * DM + h * 512 + (c - 4) * 128 + r32;
#pragma unroll
        for (int r = 0; r < 16; ++r)
#pragma unroll
            for (int d0 = 0; d0 < 4; ++d0) Ow[(size_t)crow(r, hi) * DM + d0 * 32] = (bf16)f2bf(o[d0][r]);
        asm volatile("s_waitcnt vmcnt(0)" ::: "memory"); __syncthreads();
    }
}

template <int MODE> __device__ __forceinline__ void causal_stage(LAS unsigned char* buf, const bf16* PROJ, int b, int h, int j, int wid, unsigned vk0, unsigned vk1, unsigned vv) {
    const char* base = (const char*)(PROJ + (size_t)(b * SEQ + 64 * j) * INC);
#pragma unroll
    for (int t = 0; t < 2; ++t) { const int n = 2 * wid + t; const size_t ro = (size_t)(8 * wid + 4 * t) * (INC * 2); const unsigned vk = t ? vk1 : vk0;
        if (MODE == 0) { glds16(base + ro + (1024 + h * 256) * 2 + vk, buf + n * 1024); glds16(base + ro + (1024 + h * 256 + 128) * 2 + vk, buf + 16384 + n * 1024); }
        else glds16(base + ro + (3584 + h * 128) * 2 + vk, buf + n * 1024); }
#pragma unroll
    for (int t = 0; t < 4; ++t) { const int n = 4 * wid + t;
        glds16(base + (size_t)((wid >> 1) * 16 + (wid & 1) * 4) * (INC * 2) + ((MODE == 0 ? 2048 : 4096) + h * 256 + 64 * t) * 2 + vv, buf + (MODE == 0 ? 32768 : 16384) + n * 1024); }
}
template <int MODE> __device__ __forceinline__ void causal_unit(LAS unsigned char* L, const bf16* PROJ, bf16* MIX, const float* subg, float lam, int b, int h, int i, const int wid) {
    constexpr int TILE_BYTES = MODE == 0 ? 65536 : 49152, V_OFF = MODE == 0 ? 32768 : 16384;
    constexpr float NEG = -1.0e30f, LOG2E = 1.4426950408889634f, C = 0.08838834764831845f * LOG2E;
    const int lane = lane_id_fresh();
    const int r32 = lane & 31, hi = lane >> 5;
    const int w4 = MODE == 0 ? (wid & 3) : wid, comp = MODE == 0 ? (wid >> 2) : 0;
    const int R0 = (MODE == 0 ? 128 : 256) * i + 32 * w4, NT = (MODE == 0 ? 2 : 4) * (i + 1), qpos = R0 + r32;
    const bf16* Qw = PROJ + (size_t)(b * SEQ + qpos) * INC + (MODE == 0 ? h * 256 + comp * 128 : 3072 + h * 128) + hi * 8;
    bf16x8 qr[8];
#pragma unroll
    for (int d0 = 0; d0 < 8; ++d0) qr[d0] = *(const bf16x8*)(Qw + d0 * 16);
    const float slope2 = __uint_as_float(__builtin_amdgcn_readfirstlane(__float_as_uint(MODE == 0 ? __builtin_amdgcn_exp2f(-2.0f * (float)(h + 1)) * LOG2E : -__builtin_amdgcn_logf(1.0f - __builtin_amdgcn_exp2f(-5.0f - (float)h)))));
    float m = NEG, l = 0.f; f32x16 o[8];
#pragma unroll
    for (int d0 = 0; d0 < 8; ++d0) o[d0] = f32x16{};
    LAS float* al = (LAS float*)(L + 131072 + 256 * wid); LAS float* li = al + 32;
    const int vb = v_rd_base(lane);
    unsigned vk0, vk1, vv; stage_voffs(lane, (unsigned)(INC * 2), vk0, vk1, vv);
    causal_stage<MODE>(L, PROJ, b, h, 0, wid, vk0, vk1, vv);
    asm volatile("s_waitcnt vmcnt(0)" ::: "memory"); __syncthreads();
#pragma unroll 1
    for (int j = 0; j < NT; ++j) {
        LAS unsigned char* cur = L + (j & 1) * TILE_BYTES; LAS unsigned char* nxt = L + ((j + 1) & 1) * TILE_BYTES;
        if (j + 1 < NT) causal_stage<MODE>(nxt, PROJ, b, h, j + 1, wid, vk0, vk1, vv);
        const LAS unsigned char* Kt = cur + comp * 16384; const LAS unsigned char* Vt = cur + V_OFF + vb;
#pragma unroll
        for (int hf = 0; hf < 2; ++hf) {
            const int k0 = 64 * j + 32 * hf;
            if (k0 <= R0 + 31) {
                f32x16 p = f32x16{};
                int kx = (r32 & 7) << 4; asm volatile("" : "+v"(kx));
                const LAS unsigned char* Kr = Kt + (32 * hf + r32) * 256;
#pragma unroll
                for (int d0 = 0; d0 < 8; ++d0) { const int cb = (d0 * 16 + hi * 8) * 2;
                    const bf16x8 kf = *(const LAS bf16x8*)(Kr + (cb ^ kx));
                    p = __builtin_amdgcn_mfma_f32_32x32x16_bf16(kf, qr[d0], p, 0, 0, 0); }
                const bool diag = k0 + 31 > R0;
                const float tb = slope2 * (float)(k0 + 4 * hi - qpos);
                if (MODE == 0) {
#pragma unroll
                    for (int r = 0; r < 16; ++r) p[r] = fmaf(p[r], C, tb + slope2 * (float)((r & 3) + 8 * (r >> 2)));
                    if (diag) {
#pragma unroll
                        for (int r = 0; r < 16; ++r) if (k0 + crow(r, hi) > qpos) p[r] = NEG;
                    }
                    float pmax = p[0];
#pragma unroll
                    for (int r = 1; r < 16; ++r) pmax = fmaxf(pmax, p[r]);
                    pmax = halfmax(pmax);
                    const float mn = fmaxf(m, pmax), alpha = __builtin_amdgcn_exp2f(m - mn); m = mn;
                    float ps = 0.f;
#pragma unroll
                    for (int r = 0; r < 16; ++r) { p[r] = __builtin_amdgcn_exp2f(p[r] - mn); ps += p[r]; }
                    l = l * alpha + ps;
                    if (__any(alpha < 1.0f)) {
                        if (hi == 0) al[r32] = alpha;
                        asm volatile("s_waitcnt lgkmcnt(0)" ::: "memory");
#pragma unroll
                        for (int r = 0; r < 16; ++r) { const float a = al[crow(r, hi)];
#pragma unroll
                            for (int d0 = 0; d0 < 8; ++d0) o[d0][r] *= a; }
                    }
                } else {
#pragma unroll
                    for (int r = 0; r < 16; ++r) p[r] = p[r] * 0.08838834764831845f * __builtin_amdgcn_exp2f(tb + slope2 * (float)((r & 3) + 8 * (r >> 2)));
                    if (diag) {
#pragma unroll
                        for (int r = 0; r < 16; ++r) if (k0 + crow(r, hi) > qpos) p[r] = 0.f;
                    }
                }
                bf16x8 pa0, pa1;
                ATT_PK4(p, 0, pa0); ATT_PK4(p, 8, pa1);
#pragma unroll
                for (int d0 = 0; d0 < 8; ++d0) {
#define ATT_VF(ks) ({ const s16x4 lo_ = vtr(Vt + d0 * 512 + (ks) * 8192), hh_ = vtr(Vt + d0 * 512 + (ks) * 8192 + 4096); (bf16x8){lo_[0], lo_[1], lo_[2], lo_[3], hh_[0], hh_[1], hh_[2], hh_[3]}; })
                    const bf16x8 v0 = ATT_VF(2 * hf), v1 = ATT_VF(2 * hf + 1);
#undef ATT_VF
                    o[d0] = __builtin_amdgcn_mfma_f32_32x32x16_bf16(pa0, v0, o[d0], 0, 0, 0);
                    o[d0] = __builtin_amdgcn_mfma_f32_32x32x16_bf16(pa1, v1, o[d0], 0, 0, 0); }
            }
        }
        asm volatile("s_waitcnt vmcnt(0)" ::: "memory"); __syncthreads();
    }
    float sc[16];
    if (MODE == 0) {
        l = halfsum(l);
        float lamv = lam; asm volatile("" : "+v"(lamv));
        if (hi == 0) li[r32] = (comp == 0 ? 1.0f : lamv + 0.2f) / l;
        asm volatile("s_waitcnt lgkmcnt(0)" ::: "memory");
#pragma unroll
        for (int r = 0; r < 16; ++r) sc[r] = li[crow(r, hi)];
        LAS float* EX = (LAS float*)L + (size_t)(w4 * 32) * 256 + r32;
        if (comp == 1) {
#pragma unroll
            for (int r = 0; r < 16; ++r)
#pragma unroll
                for (int d0 = 0; d0 < 8; ++d0) EX[crow(r, hi) * 256 + d0 * 32] = o[d0][r] * sc[r];
        }
        asm volatile("s_waitcnt lgkmcnt(0)" ::: "memory"); __syncthreads();
        if (comp == 0) {
#pragma unroll
            for (int r = 0; r < 16; ++r)
#pragma unroll
                for (int d0 = 0; d0 < 8; ++d0) o[d0][r] = o[d0][r] * sc[r] - EX[crow(r, hi) * 256 + d0 * 32];
        }
    }
    if (MODE == 1 || comp == 0) {
#pragma unroll
        for (int r = 0; r < 16; ++r) { float s = 0.f;
#pragma unroll
            for (int d0 = 0; d0 < 8; ++d0) s += o[d0][r] * o[d0][r];
            s += swz_xor<1>(s); s += swz_xor<2>(s); s += swz_xor<4>(s); s += swz_xor<8>(s); s += swz_xor<16>(s);
            sc[r] = (MODE == 0 ? 0.8f : 1.0f) / sqrtf(s * (1.0f / 256.0f) + NORM_EPS); }
        const size_t orow = (size_t)(b * SEQ + R0);
        if (MODE == 0) {
            float g[8];
#pragma unroll
            for (int d0 = 0; d0 < 8; ++d0) g[d0] = subg[d0 * 32 + r32];
            bf16* Ow = MIX + orow * DM + h * 256 + r32;
#pragma unroll
            for (int r = 0; r < 16; ++r)
#pragma unroll
                for (int d0 = 0; d0 < 8; ++d0) Ow[(size_t)crow(r, hi) * DM + d0 * 32] = (bf16)f2bf(o[d0][r] * sc[r] * g[d0]);
        } else {
            bf16* Ow = MIX + orow * DM + 1024 + h * 256 + r32; const bf16* Gw = PROJ + orow * INC + 5120 + h * 256 + r32;
#pragma unroll
            for (int r = 0; r < 16; ++r)
#pragma unroll
                for (int d0 = 0; d0 < 8; ++d0) { const float gt = bf2f(Gw[(size_t)crow(r, hi) * INC + d0 * 32]);
                    Ow[(size_t)crow(r, hi) * DM + d0 * 32] = (bf16)f2bf(o[d0][r] * sc[r] * (gt * __builtin_amdgcn_rcpf(1.0f + __builtin_amdgcn_exp2f(-LOG2E * gt)))); }
        }
    }
}
__device__ __forceinline__ int p2_class(int k) { const unsigned long long T0 = 0x3d509b2aeb635cfULL, T1 = 0x403110e44994d4ULL; return (int)(((k < 12 ? T0 : T1) >> (5 * (k < 12 ? k : k - 12))) & 31ULL); }
}
struct Args { const float* in[21]; float* out; unsigned char* ws; };
__global__ void __launch_bounds__(NWAVES * 64, 2) mega_fwd(Args args) {
    extern __shared__ __attribute__((aligned(16))) unsigned char lds[];
    LAS unsigned char* L = (LAS unsigned char*)lds;
    volatile LAS unsigned* MISC = (volatile LAS unsigned*)(L + MISC_OFF);
    const int wave = __builtin_amdgcn_readfirstlane((int)threadIdx.x >> 6);
#define MY_LANE() lane_id_fresh()
    const int G = gridDim.x; const int bx = blockIdx.x; const int vcu = (G % 8 == 0) ? (bx % 8) * (G / 8) + bx / 8 : bx;
    unsigned char* ws = args.ws;
    gu32* ctl = (gu32*)(ws + WS_CTL);
    const float* x = args.in[0]; const float* mem = args.in[1];
    float* out = args.out;
    bf16* Win_t = (bf16*)(ws + WS_WIN); bf16* Wo_t = (bf16*)(ws + WS_WO); bf16* Wxq_t = (bf16*)(ws + WS_WXQ); bf16* Wxkv_t = (bf16*)(ws + WS_WXKV);
    bf16* Wxo_t = (bf16*)(ws + WS_WXO); bf16* Wgu_t = (bf16*)(ws + WS_WGU); bf16* Wd_t = (bf16*)(ws + WS_WD);
    bf16* HM = (bf16*)(ws + WS_HM); bf16* XKV = (bf16*)(ws + WS_XKV); bf16* XB = (bf16*)(ws + WS_B); bf16* MIX = (bf16*)(ws + WS_C);
    bf16* PROJ = (bf16*)(ws + WS_A); bf16* XQ = (bf16*)(ws + WS_A); bf16* XO = (bf16*)(ws + WS_A + 32 * MiB); bf16* HFF = (bf16*)(ws + WS_A);
    float* ssq1 = (float*)(ws + WS_SSQ); float* ssq2 = ssq1 + MTOK; float* ssq3 = ssq2 + MTOK;
    for (int u = (int)threadIdx.x; u < (LDS_BYTES - LDSCTL_OFF) / 4; u += NWAVES * 64) ((LAS unsigned*)(L + LDSCTL_OFF))[u] = 0u;
    __syncthreads();
    XcdBarrier bar = xcd_barrier_post((unsigned*)(ctl + CW_BAR), MISC + 8);
    const int gw = vcu * NWAVES + wave, NGW = G * NWAVES;

    {
        LAS float* scr = (LAS float*)(L + RING_OFF + wave * 16384);
        const int lane = MY_LANE(), tid = wave * 64 + lane;
        constexpr int I_IN = (DM / 64) * (INC / 32), I_SQ = (DM / 64) * (DM / 32), I_FF = (DM / 64) * (DFF / 32), I_DN = (DFF / 64) * (DM / 32);
        constexpr int NITEMS = I_IN + 5 * I_SQ + 2 * I_FF + I_DN;
        for (int it = gw; it < NITEMS; it += NGW) {
            int r = it;
            if (r < I_IN) { p0_transpose_item(args.in[3], DM, INC, Win_t, 0, 0, nullptr, scr, r, lane); continue; } r -= I_IN;
            if (r < I_SQ) { p0_transpose_item(args.in[9], DM, DM, Wo_t, 0, 0, nullptr, scr, r, lane); continue; } r -= I_SQ;
            if (r < I_SQ) { p0_transpose_item(args.in[12], DM, DM, Wxq_t, 0, 0, args.in[10], scr, r, lane); continue; } r -= I_SQ;
            if (r < I_SQ) { p0_transpose_item(args.in[13], DM, DM, Wxkv_t, 0, 0, nullptr, scr, r, lane); continue; } r -= I_SQ;
            if (r < I_SQ) { p0_transpose_item(args.in[14], DM, DM, Wxkv_t, 0, DM, nullptr, scr, r, lane); continue; } r -= I_SQ;
            if (r < I_SQ) { p0_transpose_item(args.in[15], DM, DM, Wxo_t, 0, 0, nullptr, scr, r, lane); continue; } r -= I_SQ;
            if (r < I_FF) { p0_transpose_item(args.in[17], DM, DFF, Wgu_t, 1, 0, args.in[16], scr, r, lane); continue; } r -= I_FF;
            if (r < I_FF) { p0_transpose_item(args.in[18], DM, DFF, Wgu_t, 2, 0, args.in[16], scr, r, lane); continue; } r -= I_FF;
            p0_transpose_item(args.in[19], DFF, DM, Wd_t, 0, 0, nullptr, scr, r, lane);
        }
        for (int m = gw; m < MTOK; m += NGW) rms_row_to_bf16(x + (size_t)m * DM, args.in[2], XB + (size_t)m * DM, lane);
        for (int m = gw; m < MMEM; m += NGW) rms_row_to_bf16(mem + (size_t)m * DM, args.in[11], HM + (size_t)m * DM, lane);
        for (int i = bx * (NWAVES * 64) + tid; i < 3 * MTOK; i += G * NWAVES * 64) ssq1[i] = 0.f;
    }
    xcd_barrier(bar);

    {
        pg8::Gemm g{XB, Win_t, MTOK, INC, DM}; pg8::StaticOrder S; S.init(MTOK, INC, G, bx);
        pg8::EpiBf16 E{PROJ, INC};
        pg8::gemm_phase<pg8::EpiBf16, pg8::StaticOrder, true, true>(L + RING_OFF, g, S, E, wave);
    }
    {
        pg8::Gemm g{HM, Wxkv_t, MMEM, 2 * DM, DM}; pg8::StaticOrder S; S.init(MMEM, 2 * DM, G, bx);
        pg8::EpiBf16 E{XKV, 2 * DM};
        pg8::gemm_phase<pg8::EpiBf16, pg8::StaticOrder, true, true>(L + RING_OFF, g, S, E, wave);
    }
    xcd_barrier(bar);

    {
        float lam;
        { int l2 = MY_LANE(); asm volatile("" : "+v"(l2));
          const float a1 = args.in[4][l2] * args.in[5][l2] + args.in[4][l2 + 64] * args.in[5][l2 + 64];
          const float a2 = args.in[6][l2] * args.in[7][l2] + args.in[6][l2 + 64] * args.in[7][l2 + 64];
          lam = __uint_as_float(__builtin_amdgcn_readfirstlane(__float_as_uint(__expf(wave_sum(a1)) - __expf(wave_sum(a2))))); }
        for (;;) {
            __syncthreads();
            unsigned qa = MISC_OFF; asm volatile("" : "+v"(qa));
            if (wave == 0 && MY_LANE() == 0) *(volatile LAS unsigned*)(L + qa) = __hip_atomic_fetch_add((unsigned*)(ctl + CW_Q), 1u, __ATOMIC_RELAXED, __HIP_MEMORY_SCOPE_AGENT);
            __syncthreads();
            const int u = __builtin_amdgcn_readfirstlane((int)*(volatile LAS unsigned*)(L + qa));
            if (u >= 384) break;
            const int cls = att::p2_class(u >> 4), bh = u & 15;
            if (cls < 16) att::causal_unit<0>(L, PROJ, MIX, args.in[8], lam, bh >> 2, bh & 3, cls, wave);
            else att::causal_unit<1>(L, PROJ, MIX, nullptr, 0.f, bh >> 2, bh & 3, cls - 16, wave);
        }
    }
    xcd_barrier(bar);

    {
        pg8::Gemm g{MIX, Wo_t, MTOK, DM, DM}; pg8::StaticOrder S; S.init(MTOK, DM, G, bx);
        pg8::EpiRes E{x, out, XB, ssq1, DM};
        pg8::gemm_phase<pg8::EpiRes, pg8::StaticOrder, true, true>(L + RING_OFF, g, S, E, wave);
    }
    xcd_barrier(bar);

    {
        pg8::Gemm g{XB, Wxq_t, MTOK, DM, DM}; pg8::StaticOrder S; S.init(MTOK, DM, G, bx);
        pg8::EpiScaleBf16 E{XQ, DM, ssq1};
        pg8::gemm_phase<pg8::EpiScaleBf16, pg8::StaticOrder, true, true>(L + RING_OFF, g, S, E, wave);
    }
    xcd_barrier(bar);

    {
        if ((vcu & 1) == 0) { const int u = vcu >> 1, bh = u >> 3; att::xattn_unit(L, XQ, XKV, XO, bh >> 2, bh & 3, u & 7, wave); }
    }
    xcd_barrier(bar);

    {
        pg8::Gemm g{XO, Wxo_t, MTOK, DM, DM}; pg8::StaticOrder S; S.init(MTOK, DM, G, bx);
        pg8::EpiRes E{out, out, XB, ssq2, DM};
        pg8::gemm_phase<pg8::EpiRes, pg8::StaticOrder, true, true>(L + RING_OFF, g, S, E, wave);
    }
    xcd_barrier(bar);

    {
        pg8::Gemm g{XB, Wgu_t, MTOK, 2 * DFF, DM}; pg8::StaticOrder S; S.init(MTOK, 2 * DFF, G, bx);
        pg8::EpiSwiGLU E{HFF, DFF, ssq2};
        pg8::gemm_phase<pg8::EpiSwiGLU, pg8::StaticOrder, true, true>(L + RING_OFF, g, S, E, wave);
    }
    xcd_barrier(bar);

    {
        pg8::Gemm g{HFF, Wd_t, MTOK, DM, DFF}; pg8::StaticOrder S; S.init(MTOK, DM, G, bx);
        pg8::EpiRes E{out, out, nullptr, ssq3, DM};
        pg8::gemm_phase<pg8::EpiRes, pg8::StaticOrder, true, true>(L + RING_OFF, g, S, E, wave);
    }
    xcd_barrier(bar);

    int lane9 = MY_LANE(); asm volatile("" : "+v"(lane9));
    for (int m = gw; m < MTOK; m += NGW) {
        const float r = 1.0f / sqrtf(ssq3[m] * (1.0f / DM) + NORM_EPS);
        f32x4* xr = (f32x4*)(out + (size_t)m * DM) + lane9; const f32x4* gr = (const f32x4*)args.in[20] + lane9;
#pragma unroll
        for (int j = 0; j < 8; ++j) { const f32x4 v = xr[64 * j]; const f32x4 gg = gr[64 * j]; xr[64 * j] = v * r * gg; }
    }
}

extern "C" void kernel_launch(void* const* d_in, const int* in_sizes, int n_in, void* d_out, int out_size, void* d_ws, size_t ws_size, hipStream_t stream) {
    static int grid = 0;
    if (grid == 0) {
        if (n_in != 21 || in_sizes[0] != MTOK * DM || out_size != MTOK * DM || ws_size < WS_END) { fprintf(stderr, "kernel_launch: unexpected shapes / workspace (n_in %d, ws %zu)\n", n_in, ws_size); grid = -1; return; }
        int dev = 0, cus = 0, per_cu = 0;
        if (hipGetDevice(&dev) != hipSuccess || hipDeviceGetAttribute(&cus, hipDeviceAttributeMultiprocessorCount, dev) != hipSuccess) { grid = -1; return; }
        if (hipFuncSetAttribute((const void*)mega_fwd, hipFuncAttributeMaxDynamicSharedMemorySize, LDS_BYTES) != hipSuccess) { fprintf(stderr, "kernel_launch: hipFuncSetAttribute failed\n"); grid = -1; return; }
        if (hipOccupancyMaxActiveBlocksPerMultiprocessor(&per_cu, (const void*)mega_fwd, NWAVES * 64, LDS_BYTES) != hipSuccess || per_cu < 1) { fprintf(stderr, "kernel_launch: occupancy query reports %d blocks per CU\n", per_cu); (void)hipGetLastError(); grid = -1; return; }
        grid = cus;
    }
    if (grid < 0) return;
    if (hipMemsetAsync((char*)d_ws + WS_CTL, 0, CTL_ZERO_BYTES, stream) != hipSuccess) return;
    Args a{};
    for (int i = 0; i < 21; ++i) a.in[i] = (const float*)d_in[i];
    a.out = (float*)d_out; a.ws = (unsigned char*)d_ws;
    hipLaunchKernelGGL(mega_fwd, dim3(grid), dim3(NWAVES * 64), LDS_BYTES, stream, a);
}
```

```cpp
#include <hip/hip_runtime.h>
#include <cstdio>
#include <cstdint>
namespace pg8 {
#define PG8_LAS __attribute__((address_space(3)))
typedef unsigned short bf16_t;
typedef short bf16x8 __attribute__((ext_vector_type(8)));
typedef float f32x4 __attribute__((ext_vector_type(4)));
typedef unsigned u32x4 __attribute__((ext_vector_type(4)));
constexpr int BM = 256, BK = 64, HALF = 128, HTB = HALF * BK * 2  , STAGE_BYTES = 8 * HTB, NXCD = 8, WGM = 8;

__host__ __device__ __forceinline__ int lds_byte(int r, int c) { const int st = (r >> 4) * 2 + (c >> 5), rr = r & 15, cc = c & 31, ob = rr * 64 + cc * 2; return st * 1024 + (ob ^ (((ob >> 9) & 1) << 5)); }
__host__ __device__ __forceinline__ void stage_rc(int b, int& R, int& C) { const int st = b / 1024, sb = b % 1024, swz = sb ^ (((sb >> 9) & 1) << 5); R = (st >> 1) * 16 + swz / 64; C = (st & 1) * 32 + (swz % 64) / 2; }
__host__ __device__ __forceinline__ int perm32(int rho) { const int n = rho >> 4, i = rho & 15; return 8 * (i >> 2) + 4 * n + (i & 3); }

struct Unit { int pm, pn; };
struct Gemm { const bf16_t* A; const bf16_t* Bt; int M, N, K; };

struct StaticOrder {
    int nM, nN, nwg, G, c;
    __host__ __device__ void init(int M, int N, int G_, int c_) { nM = M / BM; nN = N / BM; nwg = nM * nN; G = G_; c = c_; }
    __host__ __device__ bool next(int i, Unit& u) const {
        const long L = (long)i * G + c; if (L >= nwg) return false;
        int wgid = (int)L; { const int q = nwg / NXCD, r = nwg % NXCD, xcd = wgid % NXCD, off = wgid / NXCD; wgid = (xcd < r ? xcd * (q + 1) : r * (q + 1) + (xcd - r) * q) + off; }
        const int nig = WGM * nN, gid = wgid / nig, fm = gid * WGM, gsz = (nM - fm) < WGM ? (nM - fm) : WGM;
        u.pm = fm + ((wgid % nig) % gsz); u.pn = (wgid % nig) / gsz; return true;
    }
    __device__ __forceinline__ void a_ready(const Unit&) const {}
    __device__ __forceinline__ void done(const Unit&) const {}
};

__device__ __forceinline__ unsigned cvt_pk_bf16(float lo, float hi) { unsigned r; asm volatile("v_cvt_pk_bf16_f32 %0, %1, %2" : "=v"(r) : "v"(lo), "v"(hi)); return r; }
typedef float f32x2 __attribute__((ext_vector_type(2)));
struct OneUnit { int pm, pn;
    __device__ __forceinline__ bool next(int i, Unit& u) const { if (i != 0) return false; u.pm = pm; u.pn = pn; return true; }
    __device__ __forceinline__ void a_ready(const Unit&) const {}
    __device__ __forceinline__ void done(const Unit&) const {}
};
typedef unsigned u32x2 __attribute__((ext_vector_type(2)));
struct EpiBf16 {
    static constexpr bool PERM = true, AFTER_DRAIN = false;
    bf16_t* O; int ldc;
    __device__ __forceinline__ void operator()(const f32x4 (&acc)[2][2][4][2], const Unit& u, int wr, int wc, int fr, int fq) const {
        const int row0 = u.pm * BM + wr * 64 + fr, col0 = u.pn * BM + wc * 32 + 8 * fq;
#pragma unroll
        for (int ai = 0; ai < 2; ++ai)
#pragma unroll
            for (int m = 0; m < 4; ++m) { bf16_t* rowp = O + (size_t)(row0 + ai * HALF + m * 16) * ldc + col0;
#pragma unroll
                for (int bj = 0; bj < 2; ++bj) { const f32x4 v0 = acc[ai][bj][m][0], v1 = acc[ai][bj][m][1];
                    u32x4 w; w.x = cvt_pk_bf16(v0[0], v0[1]); w.y = cvt_pk_bf16(v0[2], v0[3]); w.z = cvt_pk_bf16(v1[0], v1[1]); w.w = cvt_pk_bf16(v1[2], v1[3]);
                    *(u32x4*)(rowp + bj * HALF) = w; } }
    }
};
struct EpiScaleBf16 {
    static constexpr bool PERM = true, AFTER_DRAIN = false;
    bf16_t* O; int ldc; const float* ssq;
    __device__ __forceinline__ void operator()(const f32x4 (&acc)[2][2][4][2], const Unit& u, int wr, int wc, int fr, int fq) const {
        const int row0 = u.pm * BM + wr * 64 + fr, col0 = u.pn * BM + wc * 32 + 8 * fq;
#pragma unroll
        for (int ai = 0; ai < 2; ++ai)
#pragma unroll
            for (int m = 0; m < 4; ++m) { const int row = row0 + ai * HALF + m * 16; bf16_t* rowp = O + (size_t)row * ldc + col0;
                const float r = 1.0f / sqrtf(ssq[row] * (1.0f / 2048.0f) + 1e-6f);
#pragma unroll
                for (int bj = 0; bj < 2; ++bj) { const f32x4 v0 = acc[ai][bj][m][0] * r, v1 = acc[ai][bj][m][1] * r;
                    u32x4 w; w.x = cvt_pk_bf16(v0[0], v0[1]); w.y = cvt_pk_bf16(v0[2], v0[3]); w.z = cvt_pk_bf16(v1[0], v1[1]); w.w = cvt_pk_bf16(v1[2], v1[3]);
                    *(u32x4*)(rowp + bj * HALF) = w; } }
    }
};
__device__ __forceinline__ float silu_f(float g) { return g * __builtin_amdgcn_rcpf(1.0f + __builtin_amdgcn_exp2f(-1.4426950408889634f * g)); }
struct EpiSwiGLU {
    static constexpr bool PERM = true, AFTER_DRAIN = false;
    bf16_t* O; int ldc; const float* ssq;
    __device__ __forceinline__ void operator()(const f32x4 (&acc)[2][2][4][2], const Unit& u, int wr, int wc, int fr, int fq) const {
        const int row0 = u.pm * BM + wr * 64 + fr, col0 = u.pn * HALF + wc * 32 + 8 * fq;
#pragma unroll
        for (int ai = 0; ai < 2; ++ai)
#pragma unroll
            for (int m = 0; m < 4; ++m) { const int row = row0 + ai * HALF + m * 16; bf16_t* rowp = O + (size_t)row * ldc + col0;
                const float r = 1.0f / sqrtf(ssq[row] * (1.0f / 2048.0f) + 1e-6f);
                float h[8];
#pragma unroll
                for (int n = 0; n < 2; ++n)
#pragma unroll
                    for (int j = 0; j < 4; ++j) { const float g = acc[ai][0][m][n][j] * r, up = acc[ai][1][m][n][j] * r; h[n * 4 + j] = silu_f(g) * up; }
                u32x4 w; w.x = cvt_pk_bf16(h[0], h[1]); w.y = cvt_pk_bf16(h[2], h[3]); w.z = cvt_pk_bf16(h[4], h[5]); w.w = cvt_pk_bf16(h[6], h[7]);
                *(u32x4*)rowp = w; }
    }
};
struct EpiRes {
    static constexpr bool PERM = false, AFTER_DRAIN = false;
    const float* base; float* out; bf16_t* xb; float* ssq; int ldc;
    __device__ __forceinline__ void operator()(const f32x4 (&acc)[2][2][4][2], const Unit& u, int wr, int wc, int fr, int fq) const {
        const int row0 = u.pm * BM + wr * 64 + fr, col0 = u.pn * BM + wc * 32 + 4 * fq;
#pragma unroll
        for (int ai = 0; ai < 2; ++ai)
#pragma unroll
            for (int m = 0; m < 4; ++m) { const int row = row0 + ai * HALF + m * 16; const size_t off = (size_t)row * ldc + col0; float s = 0.f;
#pragma unroll
                for (int bj = 0; bj < 2; ++bj)
#pragma unroll
                    for (int n = 0; n < 2; ++n) { const size_t o2 = off + bj * HALF + n * 16; const f32x4 v = *(const f32x4*)(base + o2) + acc[ai][bj][m][n];
                        *(f32x4*)(out + o2) = v; s += (v[0] * v[0] + v[1] * v[1]) + (v[2] * v[2] + v[3] * v[3]);
                        if (xb) { u32x2 w; w.x = cvt_pk_bf16(v[0], v[1]); w.y = cvt_pk_bf16(v[2], v[3]); *(u32x2*)(xb + o2) = w; } }
                s += __int_as_float(__builtin_amdgcn_ds_swizzle(__float_as_int(s), (16 << 10) | 0x1f)); { auto rr = __builtin_amdgcn_permlane32_swap(__float_as_uint(s), __float_as_uint(s), false, false); s = __uint_as_float(rr[0]) + __uint_as_float(rr[1]); }
                if (fq == 0) atomicAdd(ssq + row, s);
                if (m & 1) asm volatile("" ::: "memory"); }
    }
};
template <class Epi, class Sched, bool ALIGN_EPI = false, bool SP2 = false>
__device__ __forceinline__ void gemm_phase(PG8_LAS unsigned char* lds, const Gemm g, const Sched& S, const Epi& E, const int wave_id) {
    int lane_; asm volatile("v_mbcnt_lo_u32_b32 %0, -1, 0\n\tv_mbcnt_hi_u32_b32 %0, -1, %0" : "=v"(lane_)); const int tid_ = wave_id * 64 + lane_;
    const int tid = tid_, wid = wave_id, lane = tid & 63, wr = wid >> 2, wc = wid & 3, fr = lane & 15, fq = lane >> 4;
    const int K = g.K, nt = K / BK;
    unsigned voffA[2], voffB[2];
#pragma unroll
    for (int i = 0; i < 2; ++i) { int R, C; stage_rc(tid * 16 + i * 8192, R, C); const int Rb = Epi::PERM ? ((R & ~31) + perm32(R & 31)) : R;
        voffA[i] = (unsigned)(R * K + C) * 2u; voffB[i] = (unsigned)(Rb * K + C) * 2u; }
    const size_t kstep = (size_t)(BK * 2);
    const size_t hstep = (size_t)HALF * K * 2;
    const size_t tstep = 2 * hstep;
    const unsigned ldsw = (unsigned)wid * 1024u;
    const int aoff = lds_byte(wr * 64 + fr, fq * 8), boff = lds_byte(wc * 32 + fr, fq * 8);
#define PG8_SA(b, h) (((b) * 2 + (h)) * HTB)
#define PG8_SB(b, h) ((4 + (b) * 2 + (h)) * HTB)
#define PG8_STAGE(bufoff, gbase, voff) do { _Pragma("unroll") for (int _i = 0; _i < 2; ++_i) \
        __builtin_amdgcn_global_load_lds((const unsigned*)((const char*)(gbase) + (voff)[_i]), (PG8_LAS unsigned*)(lds + (bufoff) + ldsw + _i * 8192), 16, 0, 0); } while (0)
#define PG8_LDA(dst, b, h) do { _Pragma("unroll") for (int m = 0; m < 4; ++m) _Pragma("unroll") for (int k = 0; k < 2; ++k) dst[m][k] = *(const PG8_LAS bf16x8*)(lds + PG8_SA(b, h) + aoff + m * 2048 + k * 1024); } while (0)
#define PG8_LDB(dst, b, h) do { _Pragma("unroll") for (int n = 0; n < 2; ++n) _Pragma("unroll") for (int k = 0; k < 2; ++k) dst[n][k] = *(const PG8_LAS bf16x8*)(lds + PG8_SB(b, h) + boff + n * 2048 + k * 1024); } while (0)
#define PG8_MMA(ai, bj, At, Bt) do { __builtin_amdgcn_s_setprio(1); _Pragma("unroll") for (int m = 0; m < 4; ++m) _Pragma("unroll") for (int n = 0; n < 2; ++n) _Pragma("unroll") for (int k = 0; k < 2; ++k) \
        acc[ai][bj][m][n] = __builtin_amdgcn_mfma_f32_16x16x32_bf16(Bt[n][k], At[m][k], acc[ai][bj][m][n], 0, 0, 0); __builtin_amdgcn_s_setprio(0); } while (0)
#define PG8_WAIT_V(n) asm volatile("s_waitcnt vmcnt(" #n ")" ::: "memory")
#define PG8_WAIT_L(n) asm volatile("s_waitcnt lgkmcnt(" #n ")" ::: "memory")
#define PG8_BAR __builtin_amdgcn_s_barrier()
#define PG8_SCHED __builtin_amdgcn_sched_barrier(0)
    Unit cur, nxt; int ui = 0;
    if (!S.next(0, cur)) return;
    f32x4 acc[2][2][4][2];
#pragma unroll
    for (int a = 0; a < 2; ++a)
#pragma unroll
        for (int b = 0; b < 2; ++b)
#pragma unroll
            for (int m = 0; m < 4; ++m)
#pragma unroll
                for (int n = 0; n < 2; ++n) acc[a][b][m][n] = (f32x4){0.f, 0.f, 0.f, 0.f};
    bf16x8 At[4][2], B0[2][2], B1[2][2];
    const char* cA = (const char*)g.A + (size_t)cur.pm * tstep; const char* cB = (const char*)g.Bt + (size_t)cur.pn * tstep;
    S.a_ready(cur);
    if constexpr (SP2) {
        PG8_STAGE(PG8_SB(0, 0), cB, voffB); PG8_STAGE(PG8_SB(0, 1), cB + hstep, voffB); PG8_STAGE(PG8_SA(0, 0), cA, voffA); PG8_STAGE(PG8_SA(0, 1), cA + hstep, voffA);
        if (wr == 1) PG8_BAR;
        PG8_WAIT_V(2); PG8_BAR;
        PG8_STAGE(PG8_SB(1, 0), cB + kstep, voffB); PG8_STAGE(PG8_SA(1, 0), cA + kstep, voffA); PG8_STAGE(PG8_SB(1, 1), cB + hstep + kstep, voffB);
        PG8_WAIT_V(6); PG8_BAR;
    } else {
        PG8_STAGE(PG8_SB(0, 0), cB, voffB); PG8_STAGE(PG8_SA(0, 0), cA, voffA); PG8_STAGE(PG8_SB(0, 1), cB + hstep, voffB); PG8_STAGE(PG8_SA(0, 1), cA + hstep, voffA);
        if (wr == 1) PG8_BAR;
        PG8_WAIT_V(4); PG8_BAR;
        PG8_STAGE(PG8_SB(1, 0), cB + kstep, voffB); PG8_STAGE(PG8_SA(1, 0), cA + kstep, voffA); PG8_STAGE(PG8_SB(1, 1), cB + hstep + kstep, voffB);
        PG8_WAIT_V(6); PG8_BAR;
    }
    for (;;) {
        const bool has_next = S.next(ui + 1, nxt);
        const char* nA = has_next ? (const char*)g.A + (size_t)nxt.pm * tstep : cA; const char* nB = has_next ? (const char*)g.Bt + (size_t)nxt.pn * tstep : cB;
        for (int t = 0; t < nt; t += 2) {
            const bool last = (t == nt - 2);
            const char* a1 = cA + (size_t)(t + 1) * kstep;
            const char* a2 = last ? nA : cA + (size_t)(t + 2) * kstep; const char* b2 = last ? nB : cB + (size_t)(t + 2) * kstep;
            const char* a3 = a2 + kstep; const char* b3 = b2 + kstep;
            if (last && has_next) S.a_ready(nxt);
            if constexpr (SP2) {
            PG8_LDB(B0, 0, 0); PG8_LDB(B1, 0, 1); PG8_SCHED; PG8_LDA(At, 0, 0); PG8_STAGE(PG8_SA(1, 1), a1 + hstep, voffA);
            PG8_WAIT_V(8); PG8_WAIT_L(0); PG8_BAR; PG8_MMA(0, 0, At, B0); PG8_MMA(0, 1, At, B1); PG8_BAR; PG8_SCHED;
            PG8_LDA(At, 0, 1); PG8_STAGE(PG8_SB(0, 0), b2, voffB); PG8_STAGE(PG8_SB(0, 1), b2 + hstep, voffB); PG8_STAGE(PG8_SA(0, 0), a2, voffA);
            PG8_WAIT_V(8); PG8_WAIT_L(0); PG8_BAR; PG8_MMA(1, 0, At, B0); PG8_MMA(1, 1, At, B1); PG8_BAR; PG8_SCHED;
            PG8_LDB(B0, 1, 0); PG8_LDB(B1, 1, 1); PG8_SCHED; PG8_LDA(At, 1, 0); PG8_STAGE(PG8_SA(0, 1), a2 + hstep, voffA);
            PG8_WAIT_V(8); PG8_WAIT_L(0); PG8_BAR; PG8_MMA(0, 0, At, B0); PG8_MMA(0, 1, At, B1); PG8_BAR; PG8_SCHED;
            PG8_LDA(At, 1, 1); PG8_STAGE(PG8_SB(1, 0), b3, voffB); PG8_STAGE(PG8_SB(1, 1), b3 + hstep, voffB); PG8_STAGE(PG8_SA(1, 0), a3, voffA);
            PG8_WAIT_V(8); PG8_WAIT_L(0); PG8_BAR; PG8_MMA(1, 0, At, B0); PG8_MMA(1, 1, At, B1); PG8_BAR; PG8_SCHED;
            } else {
            PG8_LDB(B0, 0, 0); PG8_SCHED; PG8_LDA(At, 0, 0); PG8_STAGE(PG8_SA(1, 1), a1 + hstep, voffA);
            PG8_WAIT_L(8); PG8_BAR; PG8_WAIT_L(0); PG8_MMA(0, 0, At, B0); PG8_BAR; PG8_SCHED;
            PG8_LDB(B1, 0, 1); PG8_STAGE(PG8_SB(0, 0), b2, voffB);
            PG8_BAR; PG8_WAIT_L(0); PG8_MMA(0, 1, At, B1); PG8_BAR;
            PG8_LDA(At, 0, 1); PG8_STAGE(PG8_SA(0, 0), a2, voffA);
            PG8_BAR; PG8_WAIT_L(0); PG8_MMA(1, 0, At, B0); PG8_BAR; PG8_SCHED;
            PG8_STAGE(PG8_SB(0, 1), b2 + hstep, voffB);
            PG8_WAIT_V(6); PG8_BAR; PG8_MMA(1, 1, At, B1); PG8_BAR;
            PG8_LDB(B0, 1, 0); PG8_SCHED; PG8_LDA(At, 1, 0); PG8_STAGE(PG8_SA(0, 1), a2 + hstep, voffA);
            PG8_WAIT_L(8); PG8_BAR; PG8_WAIT_L(0); PG8_MMA(0, 0, At, B0); PG8_BAR; PG8_SCHED;
            PG8_LDB(B1, 1, 1); PG8_STAGE(PG8_SB(1, 0), b3, voffB);
            PG8_BAR; PG8_WAIT_L(0); PG8_MMA(0, 1, At, B1); PG8_BAR;
            PG8_LDA(At, 1, 1); PG8_STAGE(PG8_SA(1, 0), a3, voffA);
            PG8_BAR; PG8_WAIT_L(0); PG8_MMA(1, 0, At, B0); PG8_BAR; PG8_SCHED;
            PG8_STAGE(PG8_SB(1, 1), b3 + hstep, voffB);
            PG8_WAIT_V(6); PG8_BAR; PG8_MMA(1, 1, At, B1); PG8_BAR;
            }
        }
        if constexpr (ALIGN_EPI) { if (wr == 0) PG8_BAR; }
        if constexpr (!Epi::AFTER_DRAIN) { int l2_; asm volatile("v_mbcnt_lo_u32_b32 %0, -1, 0\n\tv_mbcnt_hi_u32_b32 %0, -1, %0" : "=v"(l2_)); E(acc, cur, wr, wc, l2_ & 15, l2_ >> 4); S.done(cur); }
        if (!has_next) break;
#pragma unroll
        for (int a = 0; a < 2; ++a)
#pragma unroll
            for (int b = 0; b < 2; ++b)
#pragma unroll
                for (int m = 0; m < 4; ++m)
#pragma unroll
                    for (int n = 0; n < 2; ++n) acc[a][b][m][n] = (f32x4){0.f, 0.f, 0.f, 0.f};
        cur = nxt; cA = nA; cB = nB; ++ui;
        if constexpr (ALIGN_EPI) { if (wr == 1) PG8_BAR; }
    }
    PG8_WAIT_V(0);
    if constexpr (!ALIGN_EPI) { if (wr == 0) PG8_BAR; }
    PG8_BAR;
    if constexpr (Epi::AFTER_DRAIN) { E.fused(acc, cur, wr, wc, fr, fq, lds, wid, lane); S.done(cur); }
#undef PG8_SA
#undef PG8_SB
#undef PG8_STAGE
#undef PG8_LDA
#undef PG8_LDB
#undef PG8_MMA
#undef PG8_WAIT_V
#undef PG8_WAIT_L
#undef PG8_BAR
#undef PG8_SCHED
}
}

constexpr int NWAVES = 8;
constexpr int BATCH = 4, SEQ = 2048, DM = 2048, MTOK = BATCH * SEQ, MEMLEN = 256, MMEM = BATCH * MEMLEN, INC = 6144, DFF = 5632;
constexpr float NORM_EPS = 1e-6f;
constexpr size_t MiB = 1u << 20;
constexpr size_t WS_CTL = 0, CTL_ZERO_BYTES = 64 * 1024;
constexpr size_t WS_SSQ = 1 * MiB;
constexpr size_t WS_WIN = 2 * MiB, WS_WO = 26 * MiB, WS_WXQ = 34 * MiB, WS_WXKV = 42 * MiB, WS_WXO = 58 * MiB, WS_WGU = 66 * MiB, WS_WD = 110 * MiB;
constexpr size_t WS_HM = 132 * MiB, WS_XKV = 136 * MiB;
constexpr size_t WS_B = 144 * MiB;
constexpr size_t WS_C = 176 * MiB;
constexpr size_t WS_A = 208 * MiB;
constexpr size_t WS_END = 304 * MiB;
constexpr int CW_BAR = 4096, CW_Q = 8192;
constexpr int RING_OFF = 0, RING_BYTES = 131072;
constexpr int NAIVE_WAVE_BYTES = 17408;
constexpr int LDSCTL_OFF = 143360, MISC_OFF = LDSCTL_OFF + 320;
constexpr int LDS_BYTES = 147456;
static_assert(NWAVES * NAIVE_WAVE_BYTES <= LDSCTL_OFF && MISC_OFF + 128 <= LDS_BYTES, "LDS map");

#define GAS __attribute__((address_space(1)))
#define LAS __attribute__((address_space(3)))
typedef unsigned short bf16;
typedef unsigned v4u __attribute__((ext_vector_type(4)));
typedef unsigned v2u __attribute__((ext_vector_type(2)));
typedef float f32x4 __attribute__((ext_vector_type(4)));
typedef GAS unsigned gu32;
#define RLX_AGENT __ATOMIC_RELAXED, __HIP_MEMORY_SCOPE_AGENT
#define LDS_WAIT() asm volatile("s_waitcnt lgkmcnt(0)" ::: "memory")
#define VM_WAIT() asm volatile("s_waitcnt vmcnt(0)" ::: "memory")
__device__ __forceinline__ unsigned f2bf(float f) { unsigned u = __builtin_bit_cast(unsigned, f); return (u + 0x7fffu + ((u >> 16) & 1u)) >> 16; }
__device__ __forceinline__ unsigned pk2(float lo, float hi) { return f2bf(lo) | (f2bf(hi) << 16); }
__device__ __forceinline__ float bflo(unsigned w) { return __uint_as_float(w << 16); }
__device__ __forceinline__ float bfhi(unsigned w) { return __uint_as_float(w & 0xffff0000u); }
__device__ __forceinline__ float bf2f(bf16 v) { return __uint_as_float(((unsigned)v) << 16); }

#define XB_TMO      128
#define XB_XCNT(j)  (256  + 64 * (j))
#define XB_XSUB(j)  (1280 + 64 * (j))
#define XB_XGEN(j)  (2304 + 64 * (j))
#define XB_TOP      3328
#define XB_TOPGEN   3392
#define XCD_BAR_WORDS 3456
#define XB_SPIN_CAP (1u << 22)
__device__ __forceinline__ unsigned xb_ld(unsigned* p)              { return __hip_atomic_load(p, __ATOMIC_RELAXED, __HIP_MEMORY_SCOPE_AGENT); }
__device__ __forceinline__ unsigned xb_add(unsigned* p, unsigned v) { return __hip_atomic_fetch_add(p, v, __ATOMIC_RELAXED, __HIP_MEMORY_SCOPE_AGENT); }
__device__ __forceinline__ unsigned xb_xcc_id() { return (unsigned)__builtin_amdgcn_s_getreg((3 << 11) | 20) & 0xFu; }
#define XB_SPIN(cond, bar) do { unsigned _sp = 0; while (cond) { __builtin_amdgcn_s_sleep(1); \
    if ((++_sp & 255u) == 0u) { if (xb_ld(&(bar)[XB_TMO])) break; if (_sp > XB_SPIN_CAP) { atomicAdd(&(bar)[XB_TMO], 1u); break; } } } } while (0)
struct XcdBarrier { unsigned* bar; unsigned x; volatile LAS unsigned* st; };
__device__ __forceinline__ XcdBarrier xcd_barrier_post(unsigned* bar, volatile LAS unsigned* st) {
    XcdBarrier b; b.bar = bar; b.x = xb_xcc_id(); b.st = st;
    if (threadIdx.x == 0) (void)xb_add(&bar[XB_XCNT(b.x)], 1u);
    return b;
}
__device__ __forceinline__ void xcd_barrier_complete(unsigned* bar, unsigned x, unsigned& nloc, unsigned& nx) {
    const unsigned G = gridDim.x * gridDim.y * gridDim.z;
    unsigned sum, cnt, mine, sp = 0u;
    for (;;) {
        sum = 0u; cnt = 0u; mine = 0u;
#pragma unroll
        for (unsigned j = 0; j < 16; ++j) { const unsigned c = xb_ld(&bar[XB_XCNT(j)]); sum += c; cnt += (c > 0u) ? 1u : 0u; mine = (j == x) ? c : mine; }
        if (sum == G) break;
        __builtin_amdgcn_s_sleep(1);
        if ((++sp & 255u) == 0u) { if (xb_ld(&bar[XB_TMO])) break; if (sp > XB_SPIN_CAP) { atomicAdd(&bar[XB_TMO], 1u); break; } }
    }
    nloc = mine > 0u ? mine : 1u; nx = cnt > 0u ? cnt : 1u;
}
__device__ __forceinline__ void xcd_barrier(const XcdBarrier& b) {
    asm volatile("s_waitcnt vmcnt(0)" ::: "memory");
    __syncthreads();
    if (threadIdx.x == 0) {
        unsigned* bar = b.bar;
        __builtin_amdgcn_s_waitcnt(0);
        unsigned nloc = b.st[0], nx = b.st[1];
        if (nloc == 0u) { xcd_barrier_complete(bar, b.x, nloc, nx); b.st[0] = nloc; b.st[1] = nx; }
        const unsigned old = xb_add(&bar[XB_XSUB(b.x)], 1u);
        const unsigned gen = old / nloc;
        if (old + 1u == (gen + 1u) * nloc) {
            __builtin_amdgcn_fence(__ATOMIC_RELEASE, "agent");
            asm volatile("s_waitcnt vmcnt(0)" ::: "memory");
            const unsigned og = xb_add(&bar[XB_TOP], 1u);
            const unsigned tg = og / nx;
            if (og + 1u == (tg + 1u) * nx) xb_add(&bar[XB_TOPGEN], 1u);
            else XB_SPIN(xb_ld(&bar[XB_TOPGEN]) == tg, bar);
            __builtin_amdgcn_fence(__ATOMIC_ACQUIRE, "agent");
            xb_add(&bar[XB_XGEN(b.x)], 1u);
            asm volatile("s_waitcnt vmcnt(0)" ::: "memory");
        } else {
            XB_SPIN(xb_ld(&bar[XB_XGEN(b.x)]) == gen, bar);
            __builtin_amdgcn_fence(__ATOMIC_ACQUIRE, "agent");
            asm volatile("s_waitcnt vmcnt(0)" ::: "memory");
        }
    }
    __syncthreads();
}

__device__ __forceinline__ int lane_id_fresh() { int l; asm volatile("v_mbcnt_lo_u32_b32 %0, -1, 0\n\tv_mbcnt_hi_u32_b32 %0, -1, %0" : "=v"(l)); return l; }
template <int X> __device__ __forceinline__ float swz_xor(float v) { return __int_as_float(__builtin_amdgcn_ds_swizzle(__float_as_int(v), (X << 10) | 0x1f)); }
__device__ __forceinline__ float wave_sum(float v) {
    v += swz_xor<1>(v); v += swz_xor<2>(v); v += swz_xor<4>(v); v += swz_xor<8>(v); v += swz_xor<16>(v);
    auto rr = __builtin_amdgcn_permlane32_swap(__float_as_uint(v), __float_as_uint(v), false, false); return __uint_as_float(rr[0]) + __uint_as_float(rr[1]);
}
__device__ __forceinline__ float wave_max(float v) {
    v = fmaxf(v, swz_xor<1>(v)); v = fmaxf(v, swz_xor<2>(v)); v = fmaxf(v, swz_xor<4>(v)); v = fmaxf(v, swz_xor<8>(v)); v = fmaxf(v, swz_xor<16>(v));
    auto rr = __builtin_amdgcn_permlane32_swap(__float_as_uint(v), __float_as_uint(v), false, false); return fmaxf(__uint_as_float(rr[0]), __uint_as_float(rr[1]));
}

__device__ __forceinline__ void p0_transpose_item(const float* W, int K, int N, bf16* WT, int mode, int row_off, const float* gain, LAS float* scr, int item, int lane) {
    const int nblk = N / 32, kb = item / nblk, nb = item % nblk, k0 = 64 * kb, n0 = 32 * nb;
    float wv[32];
    const float* Wp = W + (size_t)(k0 + (lane >> 5)) * N + n0 + (lane & 31);
#pragma unroll
    for (int i = 0; i < 32; ++i) wv[i] = Wp[(size_t)(2 * i) * N];
    if (gain) {
#pragma unroll
        for (int i = 0; i < 32; ++i) wv[i] *= gain[k0 + 2 * i + (lane >> 5)];
    }
#pragma unroll
    for (int i = 0; i < 32; ++i) scr[(2 * i + (lane >> 5)) * 33 + (lane & 31)] = wv[i];
    LDS_WAIT(); asm volatile("" ::: "memory");
    const int c = lane & 7;
    const int r0 = (mode == 0) ? (row_off + n0) : (256 * (n0 >> 7) + 128 * (mode - 1) + (n0 & 127));
#pragma unroll
    for (int j = 0; j < 4; ++j) { const int n = (lane >> 3) + 8 * j; const LAS float* s = scr + (8 * c) * 33 + n;
        v4u o; o.x = pk2(s[0 * 33], s[1 * 33]); o.y = pk2(s[2 * 33], s[3 * 33]); o.z = pk2(s[4 * 33], s[5 * 33]); o.w = pk2(s[6 * 33], s[7 * 33]);
        *(v4u*)(WT + (size_t)(r0 + n) * K + k0 + 8 * c) = o; }
    LDS_WAIT(); asm volatile("" ::: "memory");
}
__device__ __forceinline__ void rms_row_to_bf16(const float* xrow, const float* g, bf16* orow, int lane) {
    const f32x4* xr = (const f32x4*)xrow + lane; const f32x4* gr = (const f32x4*)g + lane;
    f32x4 v[8]; float s = 0.f;
#pragma unroll
    for (int j = 0; j < 8; ++j) { v[j] = xr[64 * j]; s += (v[j].x * v[j].x + v[j].y * v[j].y) + (v[j].z * v[j].z + v[j].w * v[j].w); }
    const float r = 1.0f / sqrtf(wave_sum(s) * (1.f / DM) + NORM_EPS);
    v2u* o8 = (v2u*)orow + lane;
#pragma unroll
    for (int j = 0; j < 8; ++j) { const f32x4 gg = gr[64 * j]; v2u w; w.x = pk2(v[j].x * r * gg.x, v[j].y * r * gg.y); w.y = pk2(v[j].z * r * gg.z, v[j].w * r * gg.w); o8[64 * j] = w; }
}

__device__ __forceinline__ float dot_lds_bf16(const LAS float* q, const bf16* k, int n) {
    float s = 0.f;
    for (int d = 0; d < n; d += 8) { const v4u w = *(const v4u*)(k + d);
        s += q[d] * bflo(w.x) + q[d + 1] * bfhi(w.x) + q[d + 2] * bflo(w.y) + q[d + 3] * bfhi(w.y) + q[d + 4] * bflo(w.z) + q[d + 5] * bfhi(w.z) + q[d + 6] * bflo(w.w) + q[d + 7] * bfhi(w.w); }
    return s;
}
__device__ __forceinline__ void naive_da_item(const bf16* P, bf16* MIX, const float* subg, float lam, int b, int h, int i, LAS float* scr, int lane) {
    const size_t rowq = (size_t)(b * SEQ + i) * INC;
    LAS float* qs = scr; LAS float* tmp = scr + 256; LAS float* as = scr + 256 + 2048;
    for (int t = lane; t < 256; t += 64) qs[t] = bf2f(P[rowq + h * 256 + t]);
    LDS_WAIT(); asm volatile("" ::: "memory");
    const float slope = exp2f(-2.0f * (float)(h + 1)), scale = 0.08838834764831845f;
    for (int c = 0; c < 2; ++c) {
        float mx = -3.0e38f;
        for (int j = lane; j <= i; j += 64) {
            const bf16* kr = P + (size_t)(b * SEQ + j) * INC + 1024 + h * 256 + c * 128;
            float s = dot_lds_bf16(qs + c * 128, kr, 128);
            s = s * scale - slope * (float)(i - j);
            tmp[j] = s; mx = fmaxf(mx, s);
        }
        mx = wave_max(mx);
        float sum = 0.f;
        for (int j = lane; j <= i; j += 64) { const float p = __expf(tmp[j] - mx); tmp[j] = p; sum += p; }
        sum = wave_sum(sum);
        const float inv = 1.0f / sum;
        for (int j = lane; j <= i; j += 64) { if (c == 0) as[j] = tmp[j] * inv; else as[j] -= lam * tmp[j] * inv; }
    }
    LDS_WAIT(); asm volatile("" ::: "memory");
    float o0 = 0.f, o1 = 0.f, o2 = 0.f, o3 = 0.f;
    const bf16* vb = P + (size_t)(b * SEQ) * INC + 2048 + h * 256 + 4 * lane;
    for (int j = 0; j <= i; ++j) { const float a = as[j]; const v2u w = *(const v2u*)(vb + (size_t)j * INC);
        o0 += a * bflo(w.x); o1 += a * bfhi(w.x); o2 += a * bflo(w.y); o3 += a * bfhi(w.y); }
    const float ss = wave_sum(o0 * o0 + o1 * o1 + o2 * o2 + o3 * o3);
    const float r = 0.8f / sqrtf(ss * (1.0f / 256.0f) + NORM_EPS);
    const f32x4 g = *(const f32x4*)(subg + 4 * lane);
    v2u w; w.x = pk2(o0 * r * g.x, o1 * r * g.y); w.y = pk2(o2 * r * g.z, o3 * r * g.w);
    *(v2u*)(MIX + (size_t)(b * SEQ + i) * DM + h * 256 + 4 * lane) = w;
    LDS_WAIT(); asm volatile("" ::: "memory");
}
__device__ __forceinline__ void naive_ret_item(const bf16* P, bf16* MIX, int b, int h, int i, LAS float* scr, int lane) {
    const size_t rowq = (size_t)(b * SEQ + i) * INC;
    LAS float* qs = scr; LAS float* as = scr + 256;
    for (int t = lane; t < 128; t += 64) qs[t] = bf2f(P[rowq + 3072 + h * 128 + t]);
    LDS_WAIT(); asm volatile("" ::: "memory");
    const float lg = logf(1.0f - exp2f(-5.0f - (float)h)), scale = 0.08838834764831845f;
    for (int j = lane; j <= i; j += 64) {
        const bf16* kr = P + (size_t)(b * SEQ + j) * INC + 3584 + h * 128;
        const float s = dot_lds_bf16(qs, kr, 128);
        as[j] = s * scale * __expf(lg * (float)(i - j));
    }
    LDS_WAIT(); asm volatile("" ::: "memory");
    float o0 = 0.f, o1 = 0.f, o2 = 0.f, o3 = 0.f;
    const bf16* vb = P + (size_t)(b * SEQ) * INC + 4096 + h * 256 + 4 * lane;
    for (int j = 0; j <= i; ++j) { const float a = as[j]; const v2u w = *(const v2u*)(vb + (size_t)j * INC);
        o0 += a * bflo(w.x); o1 += a * bfhi(w.x); o2 += a * bflo(w.y); o3 += a * bfhi(w.y); }
    const float ss = wave_sum(o0 * o0 + o1 * o1 + o2 * o2 + o3 * o3);
    const float r = 1.0f / sqrtf(ss * (1.0f / 256.0f) + NORM_EPS);
    const v2u gw = *(const v2u*)(P + rowq + 5120 + h * 256 + 4 * lane);
    const float g0 = bflo(gw.x), g1 = bfhi(gw.x), g2 = bflo(gw.y), g3 = bfhi(gw.y);
    v2u w; w.x = pk2(o0 * r * (g0 / (1.0f + __expf(-g0))), o1 * r * (g1 / (1.0f + __expf(-g1)))); w.y = pk2(o2 * r * (g2 / (1.0f + __expf(-g2))), o3 * r * (g3 / (1.0f + __expf(-g3))));
    *(v2u*)(MIX + (size_t)(b * SEQ + i) * DM + 1024 + h * 256 + 4 * lane) = w;
    LDS_WAIT(); asm volatile("" ::: "memory");
}
__device__ __forceinline__ void naive_xattn_item(const bf16* XQ, const bf16* XKV, bf16* XO, int b, int h, int i, LAS float* scr, int lane) {
    const size_t rowq = (size_t)(b * SEQ + i) * DM + h * 512;
    LAS float* qs = scr; LAS float* as = scr + 512;
    for (int t = lane; t < 512; t += 64) qs[t] = bf2f(XQ[rowq + t]);
    LDS_WAIT(); asm volatile("" ::: "memory");
    const float scale = 0.044194173824159216f;
    float sc[4]; float mx = -3.0e38f;
#pragma unroll
    for (int t = 0; t < 4; ++t) { const int j = lane + 64 * t; sc[t] = dot_lds_bf16(qs, XKV + (size_t)(b * MEMLEN + j) * 4096 + h * 512, 512) * scale; mx = fmaxf(mx, sc[t]); }
    mx = wave_max(mx);
    float sum = 0.f;
#pragma unroll
    for (int t = 0; t < 4; ++t) { sc[t] = __expf(sc[t] - mx); sum += sc[t]; }
    sum = wave_sum(sum);
    const float inv = 1.0f / sum;
#pragma unroll
    for (int t = 0; t < 4; ++t) as[lane + 64 * t] = sc[t] * inv;
    LDS_WAIT(); asm volatile("" ::: "memory");
    float o[8];
#pragma unroll
    for (int e = 0; e < 8; ++e) o[e] = 0.f;
    const bf16* vb = XKV + (size_t)(b * MEMLEN) * 4096 + 2048 + h * 512 + 8 * lane;
    for (int j = 0; j < MEMLEN; ++j) { const float a = as[j]; const v4u w = *(const v4u*)(vb + (size_t)j * 4096);
        o[0] += a * bflo(w.x); o[1] += a * bfhi(w.x); o[2] += a * bflo(w.y); o[3] += a * bfhi(w.y); o[4] += a * bflo(w.z); o[5] += a * bfhi(w.z); o[6] += a * bflo(w.w); o[7] += a * bfhi(w.w); }
    v4u w; w.x = pk2(o[0], o[1]); w.y = pk2(o[2], o[3]); w.z = pk2(o[4], o[5]); w.w = pk2(o[6], o[7]);
    *(v4u*)(XO + rowq + 8 * lane) = w;
    LDS_WAIT(); asm volatile("" ::: "memory");
}


namespace att {
typedef short bf16x8 __attribute__((ext_vector_type(8)));
typedef short s16x4 __attribute__((ext_vector_type(4)));
typedef float f32x16 __attribute__((ext_vector_type(16)));
typedef unsigned u32x4 __attribute__((ext_vector_type(4)));
#define ATT_SBAR() __builtin_amdgcn_sched_barrier(0)
__device__ __forceinline__ int crow(int r, int hi) { return (r & 3) + 8 * (r >> 2) + 4 * hi; }
__device__ __forceinline__ unsigned cvtpk(float lo, float hi) { unsigned r; asm volatile("v_cvt_pk_bf16_f32 %0, %1, %2" : "=v"(r) : "v"(lo), "v"(hi)); return r; }
#define ATT_KSWZ(row, colB) ((row) * 256 + ((colB) ^ (((row) & 7) << 4)))
__device__ __forceinline__ int v_rd_base(int lane) { return ((lane & 3) << 3) | (((lane >> 2) & 3) << 6) | (((lane >> 4) & 1) << 5) | (((lane >> 5) & 1) << 8); }
__device__ __forceinline__ s16x4 vtr(const LAS unsigned char* p) { return __builtin_bit_cast(s16x4, __builtin_amdgcn_ds_read_tr16_b64_v4i16((LAS s16x4*)p)); }
#define ATT_PK4(P, BASE, OUT) do { unsigned a0_ = att::cvtpk(P[BASE + 0], P[BASE + 1]), a1_ = att::cvtpk(P[BASE + 2], P[BASE + 3]);   \
    unsigned b0_ = att::cvtpk(P[BASE + 4], P[BASE + 5]), b1_ = att::cvtpk(P[BASE + 6], P[BASE + 7]);                              \
    auto r0_ = __builtin_amdgcn_permlane32_swap(a0_, b0_, false, false); auto r1_ = __builtin_amdgcn_permlane32_swap(a1_, b1_, false, false); \
    att::u32x4 w_ = {r0_[0], r1_[0], r0_[1], r1_[1]}; OUT = __builtin_bit_cast(att::bf16x8, w_); } while (0)
__device__ __forceinline__ void glds16(const void* gsrc, LAS unsigned char* lds_dst) { __builtin_amdgcn_global_load_lds((const unsigned*)gsrc, (LAS unsigned*)lds_dst, 16, 0, 0); }
__device__ __forceinline__ void k_src(int n, int L, int& row, int& chunk) { row = 4 * n + (L >> 4); chunk = (L & 15) ^ (row & 7); }
template <int NCB> __device__ __forceinline__ void v_src(int n, int L, int& key, int& col) {
    const int off = n * 1024 + 16 * L, s = off >> 9, within = off & 511, kk7 = within >> 6, col8 = (within & 63) >> 1;
    const int kk = ((s / NCB) << 3) | kk7; key = (kk & ~0xC) | ((kk & 4) << 1) | ((kk & 8) >> 1); col = (s % NCB) * 32 + col8;
}
__device__ __forceinline__ float halfmax(float m) { auto rr = __builtin_amdgcn_permlane32_swap(__float_as_uint(m), __float_as_uint(m), false, false); return fmaxf(__uint_as_float(rr[0]), __uint_as_float(rr[1])); }
__device__ __forceinline__ float halfsum(float m) { auto rr = __builtin_amdgcn_permlane32_swap(__float_as_uint(m), __float_as_uint(m), false, false); return __uint_as_float(rr[0]) + __uint_as_float(rr[1]); }

__device__ __forceinline__ void stage_voffs(int lane, unsigned pitch, unsigned& vk0, unsigned& vk1, unsigned& vv) {
    vk0 = (unsigned)(lane >> 4) * pitch + (unsigned)(((lane & 15) ^ ((lane >> 4) & 7)) * 16);
    vk1 = (unsigned)(lane >> 4) * pitch + (unsigned)(((lane & 15) ^ ((4 + (lane >> 4)) & 7)) * 16);
    vv = (unsigned)(((lane >> 4) & 1) * 8 + ((lane >> 2) & 3)) * pitch + (unsigned)(((lane >> 5) * 32 + 8 * (lane & 3)) * 2);
}
__device__ __forceinline__ void xattn_stage(LAS unsigned char* buf, const bf16* XKV, int b, int h, int c, int wid, unsigned vk0, unsigned vk1, unsigned vv) {
    const char* base = (const char*)(XKV + (size_t)(b * MEMLEN) * 4096 + h * 512);
    if (c < 4) {
#pragma unroll
        for (int t = 0; t < 8; ++t) glds16(base + (size_t)((32 * wid + 4 * t) * 8192 + c * 256) + ((t & 1) ? vk1 : vk0), buf + (wid * 8 + t) * 1024);
    } else {
#pragma unroll
        for (int t = 0; t < 8; ++t) glds16(base + (size_t)((32 * wid + 16 * (t >> 2) + 4 * ((t >> 1) & 1)) * 8192 + (2048 + (c - 4) * 128 + 64 * (t & 1)) * 2) + vv, buf + (wid * 8 + t) * 1024);
    }
}
__device__ __forceinline__ void xattn_unit(LAS unsigned char* L, const bf16* XQ, const bf16* XKV, bf16* XO, int b, int h, int qb, const int wid) {
    const int lane = lane_id_fresh();
    const int r32 = lane & 31, hi = lane >> 5;
    const size_t row0 = (size_t)(b * SEQ + qb * 256 + wid * 32);
    const bf16* Qw = XQ + (row0 + r32) * DM + h * 512 + hi * 8;
    f32x16 p[8];
#pragma unroll
    for (int kb = 0; kb < 8; ++kb) p[kb] = f32x16{};
    bf16x8 qc[8];
#pragma unroll
    for (int d0 = 0; d0 < 8; ++d0) qc[d0] = *(const bf16x8*)(Qw + d0 * 16);
    unsigned vk0, vk1, vv; stage_voffs(lane, 8192u, vk0, vk1, vv);
    xattn_stage(L, XKV, b, h, 0, wid, vk0, vk1, vv);
    asm volatile("s_waitcnt vmcnt(0)" ::: "memory"); __syncthreads();
#pragma unroll 1
    for (int c = 0; c < 4; ++c) {
        LAS unsigned char* cur = L + (c & 1) * 65536; LAS unsigned char* nxt = L + ((c + 1) & 1) * 65536;
        xattn_stage(nxt, XKV, b, h, c + 1, wid, vk0, vk1, vv);
#pragma unroll
        for (int kb = 0; kb < 8; ++kb)
#pragma unroll
            for (int d0 = 0; d0 < 8; ++d0) { const int cb = (d0 * 16 + hi * 8) * 2;
                const bf16x8 kf = *(const LAS bf16x8*)(cur + ATT_KSWZ(kb * 32 + r32, cb));
                p[kb] = __builtin_amdgcn_mfma_f32_32x32x16_bf16(kf, qc[d0], p[kb], 0, 0, 0); }
        if (c < 3) {
#pragma unroll
            for (int d0 = 0; d0 < 8; ++d0) qc[d0] = *(const bf16x8*)(Qw + (c + 1) * 128 + d0 * 16);
        }
        asm volatile("s_waitcnt vmcnt(0)" ::: "memory"); __syncthreads();
    }
    constexpr float C = 0.044194173824159216f * 1.4426950408889634f;
    float mx = -3.0e38f;
#pragma unroll
    for (int kb = 0; kb < 8; ++kb)
#pragma unroll
        for (int r = 0; r < 16; ++r) mx = fmaxf(mx, p[kb][r]);
    mx = halfmax(mx);
    const float mC = -mx * C; float sum = 0.f;
#pragma unroll
    for (int kb = 0; kb < 8; ++kb)
#pragma unroll
        for (int r = 0; r < 16; ++r) { p[kb][r] = __builtin_amdgcn_exp2f(fmaf(p[kb][r], C, mC)); sum += p[kb][r]; }
    sum = halfsum(sum);
    const float inv = 1.0f / sum;
    bf16x8 pa[16];
#pragma unroll
    for (int kb = 0; kb < 8; ++kb) {
#pragma unroll
        for (int r = 0; r < 16; ++r) p[kb][r] *= inv;
        ATT_PK4(p[kb], 0, pa[2 * kb]); ATT_PK4(p[kb], 8, pa[2 * kb + 1]);
    }
    const int vb = v_rd_base(lane);
#pragma unroll 1
    for (int c = 4; c < 8; ++c) {
        LAS unsigned char* cur = L + (c & 1) * 65536; LAS unsigned char* nxt = L + ((c + 1) & 1) * 65536;
        if (c < 7) xattn_stage(nxt, XKV, b, h, c + 1, wid, vk0, vk1, vv);
        f32x16 o[4];
#pragma unroll
        for (int d0 = 0; d0 < 4; ++d0) { o[d0] = f32x16{};
#pragma unroll
            for (int ks = 0; ks < 16; ++ks) {
                const s16x4 lo = vtr(cur + vb + d0 * 512 + ks * 4096), hh = vtr(cur + vb + d0 * 512 + ks * 4096 + 2048);
                const bf16x8 vf = {lo[0], lo[1], lo[2], lo[3], hh[0], hh[1], hh[2], hh[3]};
                o[d0] = __builtin_amdgcn_mfma_f32_32x32x16_bf16(pa[ks], vf, o[d0], 0, 0, 0); } }
        bf16* Ow = XO + row0 * DM + h * 512 + (c - 4) * 128 + r32;
#pragma unroll
        for (int r = 0; r < 16; ++r)
#pragma unroll
            for (int d0 = 0; d0 < 4; ++d0) Ow[(size_t)crow(r, hi) * DM + d0 * 32] = (bf16)f2bf(o[d0][r]);
        asm volatile("s_waitcnt vmcnt(0)" ::: "memory"); __syncthreads();
    }
}

template <int MODE> __device__ __forceinline__ void causal_stage(LAS unsigned char* buf, const bf16* PROJ, int b, int h, int j, int wid, unsigned vk0, unsigned vk1, unsigned vv) {
    const char* base = (const char*)(PROJ + (size_t)(b * SEQ + 64 * j) * INC);
#pragma unroll
    for (int t = 0; t < 2; ++t) { const int n = 2 * wid + t; const size_t ro = (size_t)(8 * wid + 4 * t) * (INC * 2); const unsigned vk = t ? vk1 : vk0;
        if (MODE == 0) { glds16(base + ro + (1024 + h * 256) * 2 + vk, buf + n * 1024); glds16(base + ro + (1024 + h * 256 + 128) * 2 + vk, buf + 16384 + n * 1024); }
        else glds16(base + ro + (3584 + h * 128) * 2 + vk, buf + n * 1024); }
#pragma unroll
    for (int t = 0; t < 4; ++t) { const int n = 4 * wid + t;
        glds16(base + (size_t)((wid >> 1) * 16 + (wid & 1) * 4) * (INC * 2) + ((MODE == 0 ? 2048 : 4096) + h * 256 + 64 * t) * 2 + vv, buf + (MODE == 0 ? 32768 : 16384) + n * 1024); }
}
template <int MODE> __device__ __forceinline__ void causal_unit(LAS unsigned char* L, const bf16* PROJ, bf16* MIX, const float* subg, float lam, int b, int h, int i, const int wid) {
    constexpr int TILE_BYTES = MODE == 0 ? 65536 : 49152, V_OFF = MODE == 0 ? 32768 : 16384;
    constexpr float NEG = -1.0e30f, LOG2E = 1.4426950408889634f, C = 0.08838834764831845f * LOG2E;
    const int lane = lane_id_fresh();
    const int r32 = lane & 31, hi = lane >> 5;
    const int w4 = MODE == 0 ? (wid & 3) : wid, comp = MODE == 0 ? (wid >> 2) : 0;
    const int R0 = (MODE == 0 ? 128 : 256) * i + 32 * w4, NT = (MODE == 0 ? 2 : 4) * (i + 1), qpos = R0 + r32;
    const bf16* Qw = PROJ + (size_t)(b * SEQ + qpos) * INC + (MODE == 0 ? h * 256 + comp * 128 : 3072 + h * 128) + hi * 8;
    bf16x8 qr[8];
#pragma unroll
    for (int d0 = 0; d0 < 8; ++d0) qr[d0] = *(const bf16x8*)(Qw + d0 * 16);
    const float slope2 = __uint_as_float(__builtin_amdgcn_readfirstlane(__float_as_uint(MODE == 0 ? __builtin_amdgcn_exp2f(-2.0f * (float)(h + 1)) * LOG2E : -__builtin_amdgcn_logf(1.0f - __builtin_amdgcn_exp2f(-5.0f - (float)h)))));
    float m = NEG, l = 0.f; f32x16 o[8];
#pragma unroll
    for (int d0 = 0; d0 < 8; ++d0) o[d0] = f32x16{};
    LAS float* al = (LAS float*)(L + 131072 + 256 * wid); LAS float* li = al + 32;
    const int vb = v_rd_base(lane);
    unsigned vk0, vk1, vv; stage_voffs(lane, (unsigned)(INC * 2), vk0, vk1, vv);
    causal_stage<MODE>(L, PROJ, b, h, 0, wid, vk0, vk1, vv);
    asm volatile("s_waitcnt vmcnt(0)" ::: "memory"); __syncthreads();
#pragma unroll 1
    for (int j = 0; j < NT; ++j) {
        LAS unsigned char* cur = L + (j & 1) * TILE_BYTES; LAS unsigned char* nxt = L + ((j + 1) & 1) * TILE_BYTES;
        if (j + 1 < NT) causal_stage<MODE>(nxt, PROJ, b, h, j + 1, wid, vk0, vk1, vv);
        const LAS unsigned char* Kt = cur + comp * 16384; const LAS unsigned char* Vt = cur + V_OFF + vb;
#pragma unroll
        for (int hf = 0; hf < 2; ++hf) {
            const int k0 = 64 * j + 32 * hf;
            if (k0 <= R0 + 31) {
                f32x16 p = f32x16{};
                int kx = (r32 & 7) << 4; asm volatile("" : "+v"(kx));
                const LAS unsigned char* Kr = Kt + (32 * hf + r32) * 256;
#pragma unroll
                for (int d0 = 0; d0 < 8; ++d0) { const int cb = (d0 * 16 + hi * 8) * 2;
                    const bf16x8 kf = *(const LAS bf16x8*)(Kr + (cb ^ kx));
                    p = __builtin_amdgcn_mfma_f32_32x32x16_bf16(kf, qr[d0], p, 0, 0, 0); }
                const bool diag = k0 + 31 > R0;
                const float tb = slope2 * (float)(k0 + 4 * hi - qpos);
                if (MODE == 0) {
#pragma unroll
                    for (int r = 0; r < 16; ++r) p[r] = fmaf(p[r], C, tb + slope2 * (float)((r & 3) + 8 * (r >> 2)));
                    if (diag) {
#pragma unroll
                        for (int r = 0; r < 16; ++r) if (k0 + crow(r, hi) > qpos) p[r] = NEG;
                    }
                    float pmax = p[0];
#pragma unroll
                    for (int r = 1; r < 16; ++r) pmax = fmaxf(pmax, p[r]);
                    pmax = halfmax(pmax);
                    const float mn = fmaxf(m, pmax), alpha = __builtin_amdgcn_exp2f(m - mn); m = mn;
                    float ps = 0.f;
#pragma unroll
                    for (int r = 0; r < 16; ++r) { p[r] = __builtin_amdgcn_exp2f(p[r] - mn); ps += p[r]; }
                    l = l * alpha + ps;
                    if (__any(alpha < 1.0f)) {
                        if (hi == 0) al[r32] = alpha;
                        asm volatile("s_waitcnt lgkmcnt(0)" ::: "memory");
#pragma unroll
                        for (int r = 0; r < 16; ++r) { const float a = al[crow(r, hi)];
#pragma unroll
                            for (int d0 = 0; d0 < 8; ++d0) o[d0][r] *= a; }
                    }
                } else {
#pragma unroll
                    for (int r = 0; r < 16; ++r) p[r] = p[r] * 0.08838834764831845f * __builtin_amdgcn_exp2f(tb + slope2 * (float)((r & 3) + 8 * (r >> 2)));
                    if (diag) {
#pragma unroll
                        for (int r = 0; r < 16; ++r) if (k0 + crow(r, hi) > qpos) p[r] = 0.f;
                    }
                }
                bf16x8 pa0, pa1;
                ATT_PK4(p, 0, pa0); ATT_PK4(p, 8, pa1);
#pragma unroll
                for (int d0 = 0; d0 < 8; ++d0) {
#define ATT_VF(ks) ({ const s16x4 lo_ = vtr(Vt + d0 * 512 + (ks) * 8192), hh_ = vtr(Vt + d0 * 512 + (ks) * 8192 + 4096); (bf16x8){lo_[0], lo_[1], lo_[2], lo_[3], hh_[0], hh_[1], hh_[2], hh_[3]}; })
                    const bf16x8 v0 = ATT_VF(2 * hf), v1 = ATT_VF(2 * hf + 1);
#undef ATT_VF
                    o[d0] = __builtin_amdgcn_mfma_f32_32x32x16_bf16(pa0, v0, o[d0], 0, 0, 0);
                    o[d0] = __builtin_amdgcn_mfma_f32_32x32x16_bf16(pa1, v1, o[d0], 0, 0, 0); }
            }
        }
        asm volatile("s_waitcnt vmcnt(0)" ::: "memory"); __syncthreads();
    }
    float sc[16];
    if (MODE == 0) {
        l = halfsum(l);
        float lamv = lam; asm volatile("" : "+v"(lamv));
        if (hi == 0) li[r32] = (comp == 0 ? 1.0f : lamv + 0.2f) / l;
        asm volatile("s_waitcnt lgkmcnt(0)" ::: "memory");
#pragma unroll
        for (int r = 0; r < 16; ++r) sc[r] = li[crow(r, hi)];
        LAS float* EX = (LAS float*)L + (size_t)(w4 * 32) * 256 + r32;
        if (comp == 1) {
#pragma unroll
            for (int r = 0; r < 16; ++r)
#pragma unroll
                for (int d0 = 0; d0 < 8; ++d0) EX[crow(r, hi) * 256 + d0 * 32] = o[d0][r] * sc[r];
        }
        asm volatile("s_waitcnt lgkmcnt(0)" ::: "memory"); __syncthreads();
        if (comp == 0) {
#pragma unroll
            for (int r = 0; r < 16; ++r)
#pragma unroll
                for (int d0 = 0; d0 < 8; ++d0) o[d0][r] = o[d0][r] * sc[r] - EX[crow(r, hi) * 256 + d0 * 32];
        }
    }
    if (MODE == 1 || comp == 0) {
#pragma unroll
        for (int r = 0; r < 16; ++r) { float s = 0.f;
#pragma unroll
            for (int d0 = 0; d0 < 8; ++d0) s += o[d0][r] * o[d0][r];
            s += swz_xor<1>(s); s += swz_xor<2>(s); s += swz_xor<4>(s); s += swz_xor<8>(s); s += swz_xor<16>(s);
            sc[r] = (MODE == 0 ? 0.8f : 1.0f) / sqrtf(s * (1.0f / 256.0f) + NORM_EPS); }
        const size_t orow = (size_t)(b * SEQ + R0);
        if (MODE == 0) {
            float g[8];
#pragma unroll
            for (int d0 = 0; d0 < 8; ++d0) g[d0] = subg[d0 * 32 + r32];
            bf16* Ow = MIX + orow * DM + h * 256 + r32;
#pragma unroll
            for (int r = 0; r < 16; ++r)
#pragma unroll
                for (int d0 = 0; d0 < 8; ++d0) Ow[(size_t)crow(r, hi) * DM + d0 * 32] = (bf16)f2bf(o[d0][r] * sc[r] * g[d0]);
        } else {
            bf16* Ow = MIX + orow * DM + 1024 + h * 256 + r32; const bf16* Gw = PROJ + orow * INC + 5120 + h * 256 + r32;
#pragma unroll
            for (int r = 0; r < 16; ++r)
#pragma unroll
                for (int d0 = 0; d0 < 8; ++d0) { const float gt = bf2f(Gw[(size_t)crow(r, hi) * INC + d0 * 32]);
                    Ow[(size_t)crow(r, hi) * DM + d0 * 32] = (bf16)f2bf(o[d0][r] * sc[r] * (gt * __builtin_amdgcn_rcpf(1.0f + __builtin_amdgcn_exp2f(-LOG2E * gt)))); }
        }
    }
}
__device__ __forceinline__ int p2_class(int k) { const unsigned long long T0 = 0x3d509b2aeb635cfULL, T1 = 0x403110e44994d4ULL; return (int)(((k < 12 ? T0 : T1) >> (5 * (k < 12 ? k : k - 12))) & 31ULL); }
}
#ifndef PROBE_P0
#define PROBE_P0 1
#endif
#ifndef PROBE_P2
#define PROBE_P2 1
#endif
#ifndef PROBE_P4
#define PROBE_P4 1
#endif
#ifndef PROBE_P5
#define PROBE_P5 1
#endif
#ifndef PROBE_P7
#define PROBE_P7 1
#endif
struct Args { const float* in[21]; float* out; unsigned char* ws; };
__global__ void __launch_bounds__(NWAVES * 64, 2) mega_fwd(Args args) {
    extern __shared__ __attribute__((aligned(16))) unsigned char lds[];
    LAS unsigned char* L = (LAS unsigned char*)lds;
    volatile LAS unsigned* MISC = (volatile LAS unsigned*)(L + MISC_OFF);
    const int wave = __builtin_amdgcn_readfirstlane((int)threadIdx.x >> 6);
#define MY_LANE() lane_id_fresh()
    const int G = gridDim.x; const int bx = blockIdx.x; const int vcu = (G % 8 == 0) ? (bx % 8) * (G / 8) + bx / 8 : bx;
    unsigned char* ws = args.ws;
    gu32* ctl = (gu32*)(ws + WS_CTL);
    const float* x = args.in[0]; const float* mem = args.in[1];
    float* out = args.out;
    bf16* Win_t = (bf16*)(ws + WS_WIN); bf16* Wo_t = (bf16*)(ws + WS_WO); bf16* Wxq_t = (bf16*)(ws + WS_WXQ); bf16* Wxkv_t = (bf16*)(ws + WS_WXKV);
    bf16* Wxo_t = (bf16*)(ws + WS_WXO); bf16* Wgu_t = (bf16*)(ws + WS_WGU); bf16* Wd_t = (bf16*)(ws + WS_WD);
    bf16* HM = (bf16*)(ws + WS_HM); bf16* XKV = (bf16*)(ws + WS_XKV); bf16* XB = (bf16*)(ws + WS_B); bf16* MIX = (bf16*)(ws + WS_C);
    bf16* PROJ = (bf16*)(ws + WS_A); bf16* XQ = (bf16*)(ws + WS_A); bf16* XO = (bf16*)(ws + WS_A + 32 * MiB); bf16* HFF = (bf16*)(ws + WS_A);
    float* ssq1 = (float*)(ws + WS_SSQ); float* ssq2 = ssq1 + MTOK; float* ssq3 = ssq2 + MTOK;
    for (int u = (int)threadIdx.x; u < (LDS_BYTES - LDSCTL_OFF) / 4; u += NWAVES * 64) ((LAS unsigned*)(L + LDSCTL_OFF))[u] = 0u;
    __syncthreads();
    XcdBarrier bar = xcd_barrier_post((unsigned*)(ctl + CW_BAR), MISC + 8);
    const int gw = vcu * NWAVES + wave, NGW = G * NWAVES;

    for (int rep_ = 0; rep_ < PROBE_P0; ++rep_) {
        LAS float* scr = (LAS float*)(L + RING_OFF + wave * 16384);
        const int lane = MY_LANE(), tid = wave * 64 + lane;
        constexpr int I_IN = (DM / 64) * (INC / 32), I_SQ = (DM / 64) * (DM / 32), I_FF = (DM / 64) * (DFF / 32), I_DN = (DFF / 64) * (DM / 32);
        constexpr int NITEMS = I_IN + 5 * I_SQ;
        for (int it = gw; it < NITEMS; it += NGW) {
            int r = it;
            if (r < I_IN) { p0_transpose_item(args.in[3], DM, INC, Win_t, 0, 0, nullptr, scr, r, lane); continue; } r -= I_IN;
            if (r < I_SQ) { p0_transpose_item(args.in[9], DM, DM, Wo_t, 0, 0, nullptr, scr, r, lane); continue; } r -= I_SQ;
            if (r < I_SQ) { p0_transpose_item(args.in[12], DM, DM, Wxq_t, 0, 0, args.in[10], scr, r, lane); continue; } r -= I_SQ;
            if (r < I_SQ) { p0_transpose_item(args.in[13], DM, DM, Wxkv_t, 0, 0, nullptr, scr, r, lane); continue; } r -= I_SQ;
            if (r < I_SQ) { p0_transpose_item(args.in[14], DM, DM, Wxkv_t, 0, DM, nullptr, scr, r, lane); continue; } r -= I_SQ;
            p0_transpose_item(args.in[15], DM, DM, Wxo_t, 0, 0, nullptr, scr, r, lane);
        }
        for (int m = gw; m < MTOK; m += NGW) rms_row_to_bf16(x + (size_t)m * DM, args.in[2], XB + (size_t)m * DM, lane);
        for (int m = gw; m < MMEM; m += NGW) rms_row_to_bf16(mem + (size_t)m * DM, args.in[11], HM + (size_t)m * DM, lane);
        for (int i = bx * (NWAVES * 64) + tid; i < 3 * MTOK; i += G * NWAVES * 64) ssq1[i] = 0.f;
    }
    xcd_barrier(bar);

    {
        pg8::Gemm g{XB, Win_t, MTOK, INC, DM}; pg8::StaticOrder S; S.init(MTOK, INC, G, bx);
        pg8::EpiBf16 E{PROJ, INC};
        pg8::gemm_phase<pg8::EpiBf16, pg8::StaticOrder, true, true>(L + RING_OFF, g, S, E, wave);
    }
    xcd_barrier(bar);

    {
        float lam;
        { int l2 = MY_LANE(); asm volatile("" : "+v"(l2));
          const float a1 = args.in[4][l2] * args.in[5][l2] + args.in[4][l2 + 64] * args.in[5][l2 + 64];
          const float a2 = args.in[6][l2] * args.in[7][l2] + args.in[6][l2 + 64] * args.in[7][l2 + 64];
          lam = __uint_as_float(__builtin_amdgcn_readfirstlane(__float_as_uint(__expf(wave_sum(a1)) - __expf(wave_sum(a2))))); }
        for (int rep_ = 0; rep_ < PROBE_P2; ++rep_)
        for (;;) {
            __syncthreads();
            unsigned qa = MISC_OFF; asm volatile("" : "+v"(qa));
            if (wave == 0 && MY_LANE() == 0) *(volatile LAS unsigned*)(L + qa) = __hip_atomic_fetch_add((unsigned*)(ctl + CW_Q + 64 * rep_), 1u, __ATOMIC_RELAXED, __HIP_MEMORY_SCOPE_AGENT);
            __syncthreads();
            const int u0 = __builtin_amdgcn_readfirstlane((int)*(volatile LAS unsigned*)(L + qa));
            if (u0 >= 64 + 384) break;
            if (u0 < 64) {
                pg8::Gemm g{HM, Wxkv_t, MMEM, 2 * DM, DM}; pg8::OneUnit S{u0 & 3, u0 >> 2};
                pg8::EpiBf16 E{XKV, 2 * DM};
                pg8::gemm_phase<pg8::EpiBf16, pg8::OneUnit, true, true>(L + RING_OFF, g, S, E, wave);
                continue;
            }
            const int u = u0 - 64;
            const int cls = att::p2_class(u >> 4), bh = u & 15;
            if (cls < 16) att::causal_unit<0>(L, PROJ, MIX, args.in[8], lam, bh >> 2, bh & 3, cls, wave);
            else att::causal_unit<1>(L, PROJ, MIX, nullptr, 0.f, bh >> 2, bh & 3, cls - 16, wave);
        }
    }
    xcd_barrier(bar);

    {
        pg8::Gemm g{MIX, Wo_t, MTOK, DM, DM}; pg8::StaticOrder S; S.init(MTOK, DM, G, bx);
        pg8::EpiRes E{x, out, XB, ssq1, DM};
        pg8::gemm_phase<pg8::EpiRes, pg8::StaticOrder, true, true>(L + RING_OFF, g, S, E, wave);
    }
    xcd_barrier(bar);

    for (int rep_ = 0; rep_ < PROBE_P4; ++rep_) {
        pg8::Gemm g{XB, Wxq_t, MTOK, DM, DM}; pg8::StaticOrder S; S.init(MTOK, DM, G, bx);
        pg8::EpiScaleBf16 E{XQ, DM, ssq1};
        pg8::gemm_phase<pg8::EpiScaleBf16, pg8::StaticOrder, true, true>(L + RING_OFF, g, S, E, wave);
    }
    xcd_barrier(bar);

    {
        for (int rep_ = 0; rep_ < PROBE_P5; ++rep_)
        if ((vcu & 1) == 0) { const int u = vcu >> 1, bh = u >> 3; att::xattn_unit(L, XQ, XKV, XO, bh >> 2, bh & 3, u & 7, wave); }
        else {
            LAS float* scr = (LAS float*)(L + RING_OFF + wave * 16384); const int lane = MY_LANE();
            constexpr int I_FF = (DM / 64) * (DFF / 32);
            for (int it = (vcu >> 1) * NWAVES + wave; it < 2 * I_FF; it += (G / 2) * NWAVES) {
                if (it < I_FF) p0_transpose_item(args.in[17], DM, DFF, Wgu_t, 1, 0, args.in[16], scr, it, lane);
                else p0_transpose_item(args.in[18], DM, DFF, Wgu_t, 2, 0, args.in[16], scr, it - I_FF, lane);
            }
        }
    }
    xcd_barrier(bar);

    {
        pg8::Gemm g{XO, Wxo_t, MTOK, DM, DM}; pg8::StaticOrder S; S.init(MTOK, DM, G, bx);
        pg8::EpiRes E{out, out, XB, ssq2, DM};
        pg8::gemm_phase<pg8::EpiRes, pg8::StaticOrder, true, true>(L + RING_OFF, g, S, E, wave);
    }
    xcd_barrier(bar);

    for (int rep_ = 0; rep_ < PROBE_P7; ++rep_) {
        pg8::Gemm g{XB, Wgu_t, MTOK, 2 * DFF, DM}; pg8::StaticOrder S; S.init(MTOK, 2 * DFF, G, bx);
        pg8::EpiSwiGLU E{HFF, DFF, ssq2};
        pg8::gemm_phase<pg8::EpiSwiGLU, pg8::StaticOrder, true, true>(L + RING_OFF, g, S, E, wave);
        if (rep_ == 0 && bx >= 128) {
            LAS float* scr = (LAS float*)(L + RING_OFF + wave * 16384); const int lane = MY_LANE();
            constexpr int I_DN = (DFF / 64) * (DM / 32);
            for (int it = (bx - 128) * NWAVES + wave; it < I_DN; it += 128 * NWAVES) p0_transpose_item(args.in[19], DFF, DM, Wd_t, 0, 0, nullptr, scr, it, lane);
        }
    }
    xcd_barrier(bar);

    {
        pg8::Gemm g{HFF, Wd_t, MTOK, DM, DFF}; pg8::StaticOrder S; S.init(MTOK, DM, G, bx);
        pg8::EpiRes E{out, out, nullptr, ssq3, DM};
        pg8::gemm_phase<pg8::EpiRes, pg8::StaticOrder, true, true>(L + RING_OFF, g, S, E, wave);
    }
    xcd_barrier(bar);

    int lane9 = MY_LANE(); asm volatile("" : "+v"(lane9));
    for (int m = gw; m < MTOK; m += NGW) {
        const float r = 1.0f / sqrtf(ssq3[m] * (1.0f / DM) + NORM_EPS);
        f32x4* xr = (f32x4*)(out + (size_t)m * DM) + lane9; const f32x4* gr = (const f32x4*)args.in[20] + lane9;
#pragma unroll
        for (int j = 0; j < 8; ++j) { const f32x4 v = xr[64 * j]; const f32x4 gg = gr[64 * j]; xr[64 * j] = v * r * gg; }
    }
}

extern "C" void kernel_launch(void* const* d_in, const int* in_sizes, int n_in, void* d_out, int out_size, void* d_ws, size_t ws_size, hipStream_t stream) {
    static int grid = 0;
    if (grid == 0) {
        if (n_in != 21 || in_sizes[0] != MTOK * DM || out_size != MTOK * DM || ws_size < WS_END) { fprintf(stderr, "kernel_launch: unexpected shapes / workspace (n_in %d, ws %zu)\n", n_in, ws_size); grid = -1; return; }
        int dev = 0, cus = 0, per_cu = 0;
        if (hipGetDevice(&dev) != hipSuccess || hipDeviceGetAttribute(&cus, hipDeviceAttributeMultiprocessorCount, dev) != hipSuccess) { grid = -1; return; }
        if (hipFuncSetAttribute((const void*)mega_fwd, hipFuncAttributeMaxDynamicSharedMemorySize, LDS_BYTES) != hipSuccess) { fprintf(stderr, "kernel_launch: hipFuncSetAttribute failed\n"); grid = -1; return; }
        if (hipOccupancyMaxActiveBlocksPerMultiprocessor(&per_cu, (const void*)mega_fwd, NWAVES * 64, LDS_BYTES) != hipSuccess || per_cu < 1) { fprintf(stderr, "kernel_launch: occupancy query reports %d blocks per CU\n", per_cu); (void)hipGetLastError(); grid = -1; return; }
        grid = cus;
    }
    if (grid < 0) return;
    if (hipMemsetAsync((char*)d_ws + WS_CTL, 0, CTL_ZERO_BYTES, stream) != hipSuccess) return;
    Args a{};
    for (int i = 0; i < 21; ++i) a.in[i] = (const float*)d_in[i];
    a.out = (float*)d_out; a.ws = (unsigned char*)d_ws;
    hipLaunchKernelGGL(mega_fwd, dim3(grid), dim3(NWAVES * 64), LDS_BYTES, stream, a);
}
```

```cpp
#include <hip/hip_runtime.h>
#include <cstdio>
#include <cstdint>
namespace pg8 {
#define PG8_LAS __attribute__((address_space(3)))
typedef unsigned short bf16_t;
typedef short bf16x8 __attribute__((ext_vector_type(8)));
typedef float f32x4 __attribute__((ext_vector_type(4)));
typedef unsigned u32x4 __attribute__((ext_vector_type(4)));
constexpr int BM = 256, BK = 64, HALF = 128, HTB = HALF * BK * 2  , STAGE_BYTES = 8 * HTB, NXCD = 8, WGM = 8;

__host__ __device__ __forceinline__ int lds_byte(int r, int c) { const int st = (r >> 4) * 2 + (c >> 5), rr = r & 15, cc = c & 31, ob = rr * 64 + cc * 2; return st * 1024 + (ob ^ (((ob >> 9) & 1) << 5)); }
__host__ __device__ __forceinline__ void stage_rc(int b, int& R, int& C) { const int st = b / 1024, sb = b % 1024, swz = sb ^ (((sb >> 9) & 1) << 5); R = (st >> 1) * 16 + swz / 64; C = (st & 1) * 32 + (swz % 64) / 2; }
__host__ __device__ __forceinline__ int perm32(int rho) { const int n = rho >> 4, i = rho & 15; return 8 * (i >> 2) + 4 * n + (i & 3); }

struct Unit { int pm, pn; };
struct Gemm { const bf16_t* A; const bf16_t* Bt; int M, N, K; };

struct StaticOrder {
    int nM, nN, nwg, G, c;
    __host__ __device__ void init(int M, int N, int G_, int c_) { nM = M / BM; nN = N / BM; nwg = nM * nN; G = G_; c = c_; }
    __host__ __device__ bool next(int i, Unit& u) const {
        const long L = (long)i * G + c; if (L >= nwg) return false;
        int wgid = (int)L; { const int q = nwg / NXCD, r = nwg % NXCD, xcd = wgid % NXCD, off = wgid / NXCD; wgid = (xcd < r ? xcd * (q + 1) : r * (q + 1) + (xcd - r) * q) + off; }
        const int nig = WGM * nN, gid = wgid / nig, fm = gid * WGM, gsz = (nM - fm) < WGM ? (nM - fm) : WGM;
        u.pm = fm + ((wgid % nig) % gsz); u.pn = (wgid % nig) / gsz; return true;
    }
    __device__ __forceinline__ void a_ready(const Unit&) const {}
    __device__ __forceinline__ void done(const Unit&) const {}
};

__device__ __forceinline__ unsigned cvt_pk_bf16(float lo, float hi) { unsigned r; asm volatile("v_cvt_pk_bf16_f32 %0, %1, %2" : "=v"(r) : "v"(lo), "v"(hi)); return r; }
typedef float f32x2 __attribute__((ext_vector_type(2)));
struct OneUnit { int pm, pn;
    __device__ __forceinline__ bool next(int i, Unit& u) const { if (i != 0) return false; u.pm = pm; u.pn = pn; return true; }
    __device__ __forceinline__ void a_ready(const Unit&) const {}
    __device__ __forceinline__ void done(const Unit&) const {}
};
typedef unsigned u32x2 __attribute__((ext_vector_type(2)));
struct EpiBf16 {
    static constexpr bool PERM = true, AFTER_DRAIN = false;
    bf16_t* O; int ldc;
    __device__ __forceinline__ void operator()(const f32x4 (&acc)[2][2][4][2], const Unit& u, int wr, int wc, int fr, int fq) const {
        const int row0 = u.pm * BM + wr * 64 + fr, col0 = u.pn * BM + wc * 32 + 8 * fq;
#pragma unroll
        for (int ai = 0; ai < 2; ++ai)
#pragma unroll
            for (int m = 0; m < 4; ++m) { bf16_t* rowp = O + (size_t)(row0 + ai * HALF + m * 16) * ldc + col0;
#pragma unroll
                for (int bj = 0; bj < 2; ++bj) { const f32x4 v0 = acc[ai][bj][m][0], v1 = acc[ai][bj][m][1];
                    u32x4 w; w.x = cvt_pk_bf16(v0[0], v0[1]); w.y = cvt_pk_bf16(v0[2], v0[3]); w.z = cvt_pk_bf16(v1[0], v1[1]); w.w = cvt_pk_bf16(v1[2], v1[3]);
                    *(u32x4*)(rowp + bj * HALF) = w; } }
    }
};
struct EpiScaleBf16 {
    static constexpr bool PERM = true, AFTER_DRAIN = false;
    bf16_t* O; int ldc; const float* ssq;
    __device__ __forceinline__ void operator()(const f32x4 (&acc)[2][2][4][2], const Unit& u, int wr, int wc, int fr, int fq) const {
        const int row0 = u.pm * BM + wr * 64 + fr, col0 = u.pn * BM + wc * 32 + 8 * fq;
#pragma unroll
        for (int ai = 0; ai < 2; ++ai)
#pragma unroll
            for (int m = 0; m < 4; ++m) { const int row = row0 + ai * HALF + m * 16; bf16_t* rowp = O + (size_t)row * ldc + col0;
                const float r = 1.0f / sqrtf(ssq[row] * (1.0f / 2048.0f) + 1e-6f);
#pragma unroll
                for (int bj = 0; bj < 2; ++bj) { const f32x4 v0 = acc[ai][bj][m][0] * r, v1 = acc[ai][bj][m][1] * r;
                    u32x4 w; w.x = cvt_pk_bf16(v0[0], v0[1]); w.y = cvt_pk_bf16(v0[2], v0[3]); w.z = cvt_pk_bf16(v1[0], v1[1]); w.w = cvt_pk_bf16(v1[2], v1[3]);
                    *(u32x4*)(rowp + bj * HALF) = w; } }
    }
};
__device__ __forceinline__ float silu_f(float g) { return g * __builtin_amdgcn_rcpf(1.0f + __builtin_amdgcn_exp2f(-1.4426950408889634f * g)); }
struct EpiSwiGLU {
    static constexpr bool PERM = true, AFTER_DRAIN = false;
    bf16_t* O; int ldc; const float* ssq;
    __device__ __forceinline__ void operator()(const f32x4 (&acc)[2][2][4][2], const Unit& u, int wr, int wc, int fr, int fq) const {
        const int row0 = u.pm * BM + wr * 64 + fr, col0 = u.pn * HALF + wc * 32 + 8 * fq;
#pragma unroll
        for (int ai = 0; ai < 2; ++ai)
#pragma unroll
            for (int m = 0; m < 4; ++m) { const int row = row0 + ai * HALF + m * 16; bf16_t* rowp = O + (size_t)row * ldc + col0;
                const float r = 1.0f / sqrtf(ssq[row] * (1.0f / 2048.0f) + 1e-6f);
                float h[8];
#pragma unroll
                for (int n = 0; n < 2; ++n)
#pragma unroll
                    for (int j = 0; j < 4; ++j) { const float g = acc[ai][0][m][n][j] * r, up = acc[ai][1][m][n][j] * r; h[n * 4 + j] = silu_f(g) * up; }
                u32x4 w; w.x = cvt_pk_bf16(h[0], h[1]); w.y = cvt_pk_bf16(h[2], h[3]); w.z = cvt_pk_bf16(h[4], h[5]); w.w = cvt_pk_bf16(h[6], h[7]);
                *(u32x4*)rowp = w; }
    }
};
struct EpiRes {
    static constexpr bool PERM = false, AFTER_DRAIN = false;
    const float* base; float* out; bf16_t* xb; float* ssq; int ldc;
    __device__ __forceinline__ void operator()(const f32x4 (&acc)[2][2][4][2], const Unit& u, int wr, int wc, int fr, int fq) const {
        const int row0 = u.pm * BM + wr * 64 + fr, col0 = u.pn * BM + wc * 32 + 4 * fq;
#pragma unroll
        for (int ai = 0; ai < 2; ++ai)
#pragma unroll
            for (int m = 0; m < 4; ++m) { const int row = row0 + ai * HALF + m * 16; const size_t off = (size_t)row * ldc + col0; float s = 0.f;
#pragma unroll
                for (int bj = 0; bj < 2; ++bj)
#pragma unroll
                    for (int n = 0; n < 2; ++n) { const size_t o2 = off + bj * HALF + n * 16; const f32x4 v = *(const f32x4*)(base + o2) + acc[ai][bj][m][n];
                        *(f32x4*)(out + o2) = v; s += (v[0] * v[0] + v[1] * v[1]) + (v[2] * v[2] + v[3] * v[3]);
                        if (xb) { u32x2 w; w.x = cvt_pk_bf16(v[0], v[1]); w.y = cvt_pk_bf16(v[2], v[3]); *(u32x2*)(xb + o2) = w; } }
                s += __int_as_float(__builtin_amdgcn_ds_swizzle(__float_as_int(s), (16 << 10) | 0x1f)); { auto rr = __builtin_amdgcn_permlane32_swap(__float_as_uint(s), __float_as_uint(s), false, false); s = __uint_as_float(rr[0]) + __uint_as_float(rr[1]); }
                if (fq == 0) atomicAdd(ssq + row, s);
                if (m & 1) asm volatile("" ::: "memory"); }
    }
};

template <bool BASE_F32> struct EpiResB {
    static constexpr bool PERM = true, AFTER_DRAIN = false;
    const float* basef; const bf16_t* baseb; bf16_t* xo; float* ssq; int ldc;
    __device__ __forceinline__ void operator()(const f32x4 (&acc)[2][2][4][2], const Unit& u, int wr, int wc, int fr, int fq) const {
        const int row0 = u.pm * BM + wr * 64 + fr, col0 = u.pn * BM + wc * 32 + 8 * fq;
#pragma unroll
        for (int ai = 0; ai < 2; ++ai)
#pragma unroll
            for (int m = 0; m < 4; ++m) { const int row = row0 + ai * HALF + m * 16; const size_t off = (size_t)row * ldc + col0; float s = 0.f;
#pragma unroll
                for (int bj = 0; bj < 2; ++bj) { const size_t o2 = off + bj * HALF; f32x4 b0, b1;
                    if (BASE_F32) { b0 = *(const f32x4*)(basef + o2); b1 = *(const f32x4*)(basef + o2 + 4); }
                    else { const u32x4 w = *(const u32x4*)(baseb + o2);
                        b0 = (f32x4){__uint_as_float(w.x << 16), __uint_as_float(w.x & 0xffff0000u), __uint_as_float(w.y << 16), __uint_as_float(w.y & 0xffff0000u)};
                        b1 = (f32x4){__uint_as_float(w.z << 16), __uint_as_float(w.z & 0xffff0000u), __uint_as_float(w.w << 16), __uint_as_float(w.w & 0xffff0000u)}; }
                    const f32x4 v0 = b0 + acc[ai][bj][m][0], v1 = b1 + acc[ai][bj][m][1];
                    s += ((v0[0] * v0[0] + v0[1] * v0[1]) + (v0[2] * v0[2] + v0[3] * v0[3])) + ((v1[0] * v1[0] + v1[1] * v1[1]) + (v1[2] * v1[2] + v1[3] * v1[3]));
                    u32x4 w; w.x = cvt_pk_bf16(v0[0], v0[1]); w.y = cvt_pk_bf16(v0[2], v0[3]); w.z = cvt_pk_bf16(v1[0], v1[1]); w.w = cvt_pk_bf16(v1[2], v1[3]);
                    *(u32x4*)(xo + o2) = w; }
                s += __int_as_float(__builtin_amdgcn_ds_swizzle(__float_as_int(s), (16 << 10) | 0x1f)); { auto rr = __builtin_amdgcn_permlane32_swap(__float_as_uint(s), __float_as_uint(s), false, false); s = __uint_as_float(rr[0]) + __uint_as_float(rr[1]); }
                if (fq == 0) atomicAdd(ssq + row, s);
                if (m & 1) asm volatile("" ::: "memory"); }
    }
};
template <class Epi, class Sched, bool ALIGN_EPI = false, bool SP2 = false>
__device__ __forceinline__ void gemm_phase(PG8_LAS unsigned char* lds, const Gemm g, const Sched& S, const Epi& E, const int wave_id) {
    int lane_; asm volatile("v_mbcnt_lo_u32_b32 %0, -1, 0\n\tv_mbcnt_hi_u32_b32 %0, -1, %0" : "=v"(lane_)); const int tid_ = wave_id * 64 + lane_;
    const int tid = tid_, wid = wave_id, lane = tid & 63, wr = wid >> 2, wc = wid & 3, fr = lane & 15, fq = lane >> 4;
    const int K = g.K, nt = K / BK;
    unsigned voffA[2], voffB[2];
#pragma unroll
    for (int i = 0; i < 2; ++i) { int R, C; stage_rc(tid * 16 + i * 8192, R, C); const int Rb = Epi::PERM ? ((R & ~31) + perm32(R & 31)) : R;
        voffA[i] = (unsigned)(R * K + C) * 2u; voffB[i] = (unsigned)(Rb * K + C) * 2u; }
    const size_t kstep = (size_t)(BK * 2);
    const size_t hstep = (size_t)HALF * K * 2;
    const size_t tstep = 2 * hstep;
    const unsigned ldsw = (unsigned)wid * 1024u;
    const int aoff = lds_byte(wr * 64 + fr, fq * 8), boff = lds_byte(wc * 32 + fr, fq * 8);
#define PG8_SA(b, h) (((b) * 2 + (h)) * HTB)
#define PG8_SB(b, h) ((4 + (b) * 2 + (h)) * HTB)
#define PG8_STAGE(bufoff, gbase, voff) do { _Pragma("unroll") for (int _i = 0; _i < 2; ++_i) \
        __builtin_amdgcn_global_load_lds((const unsigned*)((const char*)(gbase) + (voff)[_i]), (PG8_LAS unsigned*)(lds + (bufoff) + ldsw + _i * 8192), 16, 0, 0); } while (0)
#define PG8_LDA(dst, b, h) do { _Pragma("unroll") for (int m = 0; m < 4; ++m) _Pragma("unroll") for (int k = 0; k < 2; ++k) dst[m][k] = *(const PG8_LAS bf16x8*)(lds + PG8_SA(b, h) + aoff + m * 2048 + k * 1024); } while (0)
#define PG8_LDB(dst, b, h) do { _Pragma("unroll") for (int n = 0; n < 2; ++n) _Pragma("unroll") for (int k = 0; k < 2; ++k) dst[n][k] = *(const PG8_LAS bf16x8*)(lds + PG8_SB(b, h) + boff + n * 2048 + k * 1024); } while (0)
#define PG8_MMA(ai, bj, At, Bt) do { __builtin_amdgcn_s_setprio(1); _Pragma("unroll") for (int m = 0; m < 4; ++m) _Pragma("unroll") for (int n = 0; n < 2; ++n) _Pragma("unroll") for (int k = 0; k < 2; ++k) \
        acc[ai][bj][m][n] = __builtin_amdgcn_mfma_f32_16x16x32_bf16(Bt[n][k], At[m][k], acc[ai][bj][m][n], 0, 0, 0); __builtin_amdgcn_s_setprio(0); } while (0)
#define PG8_WAIT_V(n) asm volatile("s_waitcnt vmcnt(" #n ")" ::: "memory")
#define PG8_WAIT_L(n) asm volatile("s_waitcnt lgkmcnt(" #n ")" ::: "memory")
#define PG8_BAR __builtin_amdgcn_s_barrier()
#define PG8_SCHED __builtin_amdgcn_sched_barrier(0)
    Unit cur, nxt; int ui = 0;
    if (!S.next(0, cur)) return;
    f32x4 acc[2][2][4][2];
#pragma unroll
    for (int a = 0; a < 2; ++a)
#pragma unroll
        for (int b = 0; b < 2; ++b)
#pragma unroll
            for (int m = 0; m < 4; ++m)
#pragma unroll
                for (int n = 0; n < 2; ++n) acc[a][b][m][n] = (f32x4){0.f, 0.f, 0.f, 0.f};
    bf16x8 At[4][2], B0[2][2], B1[2][2];
    const char* cA = (const char*)g.A + (size_t)cur.pm * tstep; const char* cB = (const char*)g.Bt + (size_t)cur.pn * tstep;
    S.a_ready(cur);
    if constexpr (SP2) {
        PG8_STAGE(PG8_SB(0, 0), cB, voffB); PG8_STAGE(PG8_SB(0, 1), cB + hstep, voffB); PG8_STAGE(PG8_SA(0, 0), cA, voffA); PG8_STAGE(PG8_SA(0, 1), cA + hstep, voffA);
        if (wr == 1) PG8_BAR;
        PG8_WAIT_V(2); PG8_BAR;
        PG8_STAGE(PG8_SB(1, 0), cB + kstep, voffB); PG8_STAGE(PG8_SA(1, 0), cA + kstep, voffA); PG8_STAGE(PG8_SB(1, 1), cB + hstep + kstep, voffB);
        PG8_WAIT_V(6); PG8_BAR;
    } else {
        PG8_STAGE(PG8_SB(0, 0), cB, voffB); PG8_STAGE(PG8_SA(0, 0), cA, voffA); PG8_STAGE(PG8_SB(0, 1), cB + hstep, voffB); PG8_STAGE(PG8_SA(0, 1), cA + hstep, voffA);
        if (wr == 1) PG8_BAR;
        PG8_WAIT_V(4); PG8_BAR;
        PG8_STAGE(PG8_SB(1, 0), cB + kstep, voffB); PG8_STAGE(PG8_SA(1, 0), cA + kstep, voffA); PG8_STAGE(PG8_SB(1, 1), cB + hstep + kstep, voffB);
        PG8_WAIT_V(6); PG8_BAR;
    }
    for (;;) {
        const bool has_next = S.next(ui + 1, nxt);
        const char* nA = has_next ? (const char*)g.A + (size_t)nxt.pm * tstep : cA; const char* nB = has_next ? (const char*)g.Bt + (size_t)nxt.pn * tstep : cB;
        for (int t = 0; t < nt; t += 2) {
            const bool last = (t == nt - 2);
            const char* a1 = cA + (size_t)(t + 1) * kstep;
            const char* a2 = last ? nA : cA + (size_t)(t + 2) * kstep; const char* b2 = last ? nB : cB + (size_t)(t + 2) * kstep;
            const char* a3 = a2 + kstep; const char* b3 = b2 + kstep;
            if (last && has_next) S.a_ready(nxt);
            if constexpr (SP2) {
            PG8_LDB(B0, 0, 0); PG8_LDB(B1, 0, 1); PG8_SCHED; PG8_LDA(At, 0, 0); PG8_STAGE(PG8_SA(1, 1), a1 + hstep, voffA);
            PG8_WAIT_V(8); PG8_WAIT_L(0); PG8_BAR; PG8_MMA(0, 0, At, B0); PG8_MMA(0, 1, At, B1); PG8_BAR; PG8_SCHED;
            PG8_LDA(At, 0, 1); PG8_STAGE(PG8_SB(0, 0), b2, voffB); PG8_STAGE(PG8_SB(0, 1), b2 + hstep, voffB); PG8_STAGE(PG8_SA(0, 0), a2, voffA);
            PG8_WAIT_V(8); PG8_WAIT_L(0); PG8_BAR; PG8_MMA(1, 0, At, B0); PG8_MMA(1, 1, At, B1); PG8_BAR; PG8_SCHED;
            PG8_LDB(B0, 1, 0); PG8_LDB(B1, 1, 1); PG8_SCHED; PG8_LDA(At, 1, 0); PG8_STAGE(PG8_SA(0, 1), a2 + hstep, voffA);
            PG8_WAIT_V(8); PG8_WAIT_L(0); PG8_BAR; PG8_MMA(0, 0, At, B0); PG8_MMA(0, 1, At, B1); PG8_BAR; PG8_SCHED;
            PG8_LDA(At, 1, 1); PG8_STAGE(PG8_SB(1, 0), b3, voffB); PG8_STAGE(PG8_SB(1, 1), b3 + hstep, voffB); PG8_STAGE(PG8_SA(1, 0), a3, voffA);
            PG8_WAIT_V(8); PG8_WAIT_L(0); PG8_BAR; PG8_MMA(1, 0, At, B0); PG8_MMA(1, 1, At, B1); PG8_BAR; PG8_SCHED;
            } else {
            PG8_LDB(B0, 0, 0); PG8_SCHED; PG8_LDA(At, 0, 0); PG8_STAGE(PG8_SA(1, 1), a1 + hstep, voffA);
            PG8_WAIT_L(8); PG8_BAR; PG8_WAIT_L(0); PG8_MMA(0, 0, At, B0); PG8_BAR; PG8_SCHED;
            PG8_LDB(B1, 0, 1); PG8_STAGE(PG8_SB(0, 0), b2, voffB);
            PG8_BAR; PG8_WAIT_L(0); PG8_MMA(0, 1, At, B1); PG8_BAR;
            PG8_LDA(At, 0, 1); PG8_STAGE(PG8_SA(0, 0), a2, voffA);
            PG8_BAR; PG8_WAIT_L(0); PG8_MMA(1, 0, At, B0); PG8_BAR; PG8_SCHED;
            PG8_STAGE(PG8_SB(0, 1), b2 + hstep, voffB);
            PG8_WAIT_V(6); PG8_BAR; PG8_MMA(1, 1, At, B1); PG8_BAR;
            PG8_LDB(B0, 1, 0); PG8_SCHED; PG8_LDA(At, 1, 0); PG8_STAGE(PG8_SA(0, 1), a2 + hstep, voffA);
            PG8_WAIT_L(8); PG8_BAR; PG8_WAIT_L(0); PG8_MMA(0, 0, At, B0); PG8_BAR; PG8_SCHED;
            PG8_LDB(B1, 1, 1); PG8_STAGE(PG8_SB(1, 0), b3, voffB);
            PG8_BAR; PG8_WAIT_L(0); PG8_MMA(0, 1, At, B1); PG8_BAR;
            PG8_LDA(At, 1, 1); PG8_STAGE(PG8_SA(1, 0), a3, voffA);
            PG8_BAR; PG8_WAIT_L(0); PG8_MMA(1, 0, At, B0); PG8_BAR; PG8_SCHED;
            PG8_STAGE(PG8_SB(1, 1), b3 + hstep, voffB);
            PG8_WAIT_V(6); PG8_BAR; PG8_MMA(1, 1, At, B1); PG8_BAR;
            }
        }
        if constexpr (ALIGN_EPI) { if (wr == 0) PG8_BAR; }
        if constexpr (!Epi::AFTER_DRAIN) { int l2_; asm volatile("v_mbcnt_lo_u32_b32 %0, -1, 0\n\tv_mbcnt_hi_u32_b32 %0, -1, %0" : "=v"(l2_)); E(acc, cur, wr, wc, l2_ & 15, l2_ >> 4); S.done(cur); }
        if (!has_next) break;
#pragma unroll
        for (int a = 0; a < 2; ++a)
#pragma unroll
            for (int b = 0; b < 2; ++b)
#pragma unroll
                for (int m = 0; m < 4; ++m)
#pragma unroll
                    for (int n = 0; n < 2; ++n) acc[a][b][m][n] = (f32x4){0.f, 0.f, 0.f, 0.f};
        cur = nxt; cA = nA; cB = nB; ++ui;
        if constexpr (ALIGN_EPI) { if (wr == 1) PG8_BAR; }
    }
    PG8_WAIT_V(0);
    if constexpr (!ALIGN_EPI) { if (wr == 0) PG8_BAR; }
    PG8_BAR;
    if constexpr (Epi::AFTER_DRAIN) { E.fused(acc, cur, wr, wc, fr, fq, lds, wid, lane); S.done(cur); }
#undef PG8_SA
#undef PG8_SB
#undef PG8_STAGE
#undef PG8_LDA
#undef PG8_LDB
#undef PG8_MMA
#undef PG8_WAIT_V
#undef PG8_WAIT_L
#undef PG8_BAR
#undef PG8_SCHED
}
}

constexpr int NWAVES = 8;
constexpr int BATCH = 4, SEQ = 2048, DM = 2048, MTOK = BATCH * SEQ, MEMLEN = 256, MMEM = BATCH * MEMLEN, INC = 6144, DFF = 5632;
constexpr float NORM_EPS = 1e-6f;
constexpr size_t MiB = 1u << 20;
constexpr size_t WS_CTL = 0, CTL_ZERO_BYTES = 64 * 1024;
constexpr size_t WS_SSQ = 1 * MiB;
constexpr size_t WS_WIN = 2 * MiB, WS_WO = 26 * MiB, WS_WXQ = 34 * MiB, WS_WXKV = 42 * MiB, WS_WXO = 58 * MiB, WS_WGU = 66 * MiB, WS_WD = 110 * MiB;
constexpr size_t WS_HM = 132 * MiB, WS_XKV = 136 * MiB;
constexpr size_t WS_B = 144 * MiB;
constexpr size_t WS_C = 176 * MiB;
constexpr size_t WS_A = 208 * MiB;
constexpr size_t WS_END = 304 * MiB;
constexpr int CW_BAR = 4096, CW_Q = 8192;
constexpr int RING_OFF = 0, RING_BYTES = 131072;
constexpr int NAIVE_WAVE_BYTES = 17408;
constexpr int LDSCTL_OFF = 143360, MISC_OFF = LDSCTL_OFF + 320;
constexpr int LDS_BYTES = 147456;
static_assert(NWAVES * NAIVE_WAVE_BYTES <= LDSCTL_OFF && MISC_OFF + 128 <= LDS_BYTES, "LDS map");

#define GAS __attribute__((address_space(1)))
#define LAS __attribute__((address_space(3)))
typedef unsigned short bf16;
typedef unsigned v4u __attribute__((ext_vector_type(4)));
typedef unsigned v2u __attribute__((ext_vector_type(2)));
typedef float f32x4 __attribute__((ext_vector_type(4)));
typedef GAS unsigned gu32;
#define RLX_AGENT __ATOMIC_RELAXED, __HIP_MEMORY_SCOPE_AGENT
#define LDS_WAIT() asm volatile("s_waitcnt lgkmcnt(0)" ::: "memory")
#define VM_WAIT() asm volatile("s_waitcnt vmcnt(0)" ::: "memory")
__device__ __forceinline__ unsigned f2bf(float f) { unsigned u = __builtin_bit_cast(unsigned, f); return (u + 0x7fffu + ((u >> 16) & 1u)) >> 16; }
__device__ __forceinline__ unsigned pk2(float lo, float hi) { return f2bf(lo) | (f2bf(hi) << 16); }
__device__ __forceinline__ float bflo(unsigned w) { return __uint_as_float(w << 16); }
__device__ __forceinline__ float bfhi(unsigned w) { return __uint_as_float(w & 0xffff0000u); }
__device__ __forceinline__ float bf2f(bf16 v) { return __uint_as_float(((unsigned)v) << 16); }

#define XB_TMO      128
#define XB_XCNT(j)  (256  + 64 * (j))
#define XB_XSUB(j)  (1280 + 64 * (j))
#define XB_XGEN(j)  (2304 + 64 * (j))
#define XB_TOP      3328
#define XB_TOPGEN   3392
#define XCD_BAR_WORDS 3456
#define XB_SPIN_CAP (1u << 22)
__device__ __forceinline__ unsigned xb_ld(unsigned* p)              { return __hip_atomic_load(p, __ATOMIC_RELAXED, __HIP_MEMORY_SCOPE_AGENT); }
__device__ __forceinline__ unsigned xb_add(unsigned* p, unsigned v) { return __hip_atomic_fetch_add(p, v, __ATOMIC_RELAXED, __HIP_MEMORY_SCOPE_AGENT); }
__device__ __forceinline__ unsigned xb_xcc_id() { return (unsigned)__builtin_amdgcn_s_getreg((3 << 11) | 20) & 0xFu; }
#define XB_SPIN(cond, bar) do { unsigned _sp = 0; while (cond) { __builtin_amdgcn_s_sleep(1); \
    if ((++_sp & 255u) == 0u) { if (xb_ld(&(bar)[XB_TMO])) break; if (_sp > XB_SPIN_CAP) { atomicAdd(&(bar)[XB_TMO], 1u); break; } } } } while (0)
struct XcdBarrier { unsigned* bar; unsigned x; volatile LAS unsigned* st; };
__device__ __forceinline__ XcdBarrier xcd_barrier_post(unsigned* bar, volatile LAS unsigned* st) {
    XcdBarrier b; b.bar = bar; b.x = xb_xcc_id(); b.st = st;
    if (threadIdx.x == 0) (void)xb_add(&bar[XB_XCNT(b.x)], 1u);
    return b;
}
__device__ __forceinline__ void xcd_barrier_complete(unsigned* bar, unsigned x, unsigned& nloc, unsigned& nx) {
    const unsigned G = gridDim.x * gridDim.y * gridDim.z;
    unsigned sum, cnt, mine, sp = 0u;
    for (;;) {
        sum = 0u; cnt = 0u; mine = 0u;
#pragma unroll
        for (unsigned j = 0; j < 16; ++j) { const unsigned c = xb_ld(&bar[XB_XCNT(j)]); sum += c; cnt += (c > 0u) ? 1u : 0u; mine = (j == x) ? c : mine; }
        if (sum == G) break;
        __builtin_amdgcn_s_sleep(1);
        if ((++sp & 255u) == 0u) { if (xb_ld(&bar[XB_TMO])) break; if (sp > XB_SPIN_CAP) { atomicAdd(&bar[XB_TMO], 1u); break; } }
    }
    nloc = mine > 0u ? mine : 1u; nx = cnt > 0u ? cnt : 1u;
}
__device__ __forceinline__ void xcd_barrier(const XcdBarrier& b) {
    asm volatile("s_waitcnt vmcnt(0)" ::: "memory");
    __syncthreads();
    if (threadIdx.x == 0) {
        unsigned* bar = b.bar;
        __builtin_amdgcn_s_waitcnt(0);
        unsigned nloc = b.st[0], nx = b.st[1];
        if (nloc == 0u) { xcd_barrier_complete(bar, b.x, nloc, nx); b.st[0] = nloc; b.st[1] = nx; }
        const unsigned old = xb_add(&bar[XB_XSUB(b.x)], 1u);
        const unsigned gen = old / nloc;
        if (old + 1u == (gen + 1u) * nloc) {
            __builtin_amdgcn_fence(__ATOMIC_RELEASE, "agent");
            asm volatile("s_waitcnt vmcnt(0)" ::: "memory");
            const unsigned og = xb_add(&bar[XB_TOP], 1u);
            const unsigned tg = og / nx;
            if (og + 1u == (tg + 1u) * nx) xb_add(&bar[XB_TOPGEN], 1u);
            else XB_SPIN(xb_ld(&bar[XB_TOPGEN]) == tg, bar);
            __builtin_amdgcn_fence(__ATOMIC_ACQUIRE, "agent");
            xb_add(&bar[XB_XGEN(b.x)], 1u);
            asm volatile("s_waitcnt vmcnt(0)" ::: "memory");
        } else {
            XB_SPIN(xb_ld(&bar[XB_XGEN(b.x)]) == gen, bar);
            __builtin_amdgcn_fence(__ATOMIC_ACQUIRE, "agent");
            asm volatile("s_waitcnt vmcnt(0)" ::: "memory");
        }
    }
    __syncthreads();
}

__device__ __forceinline__ int lane_id_fresh() { int l; asm volatile("v_mbcnt_lo_u32_b32 %0, -1, 0\n\tv_mbcnt_hi_u32_b32 %0, -1, %0" : "=v"(l)); return l; }
template <int X> __device__ __forceinline__ float swz_xor(float v) { return __int_as_float(__builtin_amdgcn_ds_swizzle(__float_as_int(v), (X << 10) | 0x1f)); }
__device__ __forceinline__ float wave_sum(float v) {
    v += swz_xor<1>(v); v += swz_xor<2>(v); v += swz_xor<4>(v); v += swz_xor<8>(v); v += swz_xor<16>(v);
    auto rr = __builtin_amdgcn_permlane32_swap(__float_as_uint(v), __float_as_uint(v), false, false); return __uint_as_float(rr[0]) + __uint_as_float(rr[1]);
}
__device__ __forceinline__ float wave_max(float v) {
    v = fmaxf(v, swz_xor<1>(v)); v = fmaxf(v, swz_xor<2>(v)); v = fmaxf(v, swz_xor<4>(v)); v = fmaxf(v, swz_xor<8>(v)); v = fmaxf(v, swz_xor<16>(v));
    auto rr = __builtin_amdgcn_permlane32_swap(__float_as_uint(v), __float_as_uint(v), false, false); return fmaxf(__uint_as_float(rr[0]), __uint_as_float(rr[1]));
}

__device__ __forceinline__ void p0_transpose_item(const float* W, int K, int N, bf16* WT, int mode, int row_off, const float* gain, LAS float* scr, int item, int lane) {
    const int nblk = N / 32, kb = item / nblk, nb = item % nblk, k0 = 64 * kb, n0 = 32 * nb;
    float wv[32];
    const float* Wp = W + (size_t)(k0 + (lane >> 5)) * N + n0 + (lane & 31);
#pragma unroll
    for (int i = 0; i < 32; ++i) wv[i] = Wp[(size_t)(2 * i) * N];
    if (gain) {
#pragma unroll
        for (int i = 0; i < 32; ++i) wv[i] *= gain[k0 + 2 * i + (lane >> 5)];
    }
#pragma unroll
    for (int i = 0; i < 32; ++i) scr[(2 * i + (lane >> 5)) * 33 + (lane & 31)] = wv[i];
    LDS_WAIT(); asm volatile("" ::: "memory");
    const int c = lane & 7;
    const int r0 = (mode == 0) ? (row_off + n0) : (256 * (n0 >> 7) + 128 * (mode - 1) + (n0 & 127));
#pragma unroll
    for (int j = 0; j < 4; ++j) { const int n = (lane >> 3) + 8 * j; const LAS float* s = scr + (8 * c) * 33 + n;
        v4u o; o.x = pk2(s[0 * 33], s[1 * 33]); o.y = pk2(s[2 * 33], s[3 * 33]); o.z = pk2(s[4 * 33], s[5 * 33]); o.w = pk2(s[6 * 33], s[7 * 33]);
        *(v4u*)(WT + (size_t)(r0 + n) * K + k0 + 8 * c) = o; }
    LDS_WAIT(); asm volatile("" ::: "memory");
}
__device__ __forceinline__ void rms_row_to_bf16(const float* xrow, const float* g, bf16* orow, int lane) {
    const f32x4* xr = (const f32x4*)xrow + lane; const f32x4* gr = (const f32x4*)g + lane;
    f32x4 v[8]; float s = 0.f;
#pragma unroll
    for (int j = 0; j < 8; ++j) { v[j] = xr[64 * j]; s += (v[j].x * v[j].x + v[j].y * v[j].y) + (v[j].z * v[j].z + v[j].w * v[j].w); }
    const float r = 1.0f / sqrtf(wave_sum(s) * (1.f / DM) + NORM_EPS);
    v2u* o8 = (v2u*)orow + lane;
#pragma unroll
    for (int j = 0; j < 8; ++j) { const f32x4 gg = gr[64 * j]; v2u w; w.x = pk2(v[j].x * r * gg.x, v[j].y * r * gg.y); w.y = pk2(v[j].z * r * gg.z, v[j].w * r * gg.w); o8[64 * j] = w; }
}

__device__ __forceinline__ float dot_lds_bf16(const LAS float* q, const bf16* k, int n) {
    float s = 0.f;
    for (int d = 0; d < n; d += 8) { const v4u w = *(const v4u*)(k + d);
        s += q[d] * bflo(w.x) + q[d + 1] * bfhi(w.x) + q[d + 2] * bflo(w.y) + q[d + 3] * bfhi(w.y) + q[d + 4] * bflo(w.z) + q[d + 5] * bfhi(w.z) + q[d + 6] * bflo(w.w) + q[d + 7] * bfhi(w.w); }
    return s;
}
__device__ __forceinline__ void naive_da_item(const bf16* P, bf16* MIX, const float* subg, float lam, int b, int h, int i, LAS float* scr, int lane) {
    const size_t rowq = (size_t)(b * SEQ + i) * INC;
    LAS float* qs = scr; LAS float* tmp = scr + 256; LAS float* as = scr + 256 + 2048;
    for (int t = lane; t < 256; t += 64) qs[t] = bf2f(P[rowq + h * 256 + t]);
    LDS_WAIT(); asm volatile("" ::: "memory");
    const float slope = exp2f(-2.0f * (float)(h + 1)), scale = 0.08838834764831845f;
    for (int c = 0; c < 2; ++c) {
        float mx = -3.0e38f;
        for (int j = lane; j <= i; j += 64) {
            const bf16* kr = P + (size_t)(b * SEQ + j) * INC + 1024 + h * 256 + c * 128;
            float s = dot_lds_bf16(qs + c * 128, kr, 128);
            s = s * scale - slope * (float)(i - j);
            tmp[j] = s; mx = fmaxf(mx, s);
        }
        mx = wave_max(mx);
        float sum = 0.f;
        for (int j = lane; j <= i; j += 64) { const float p = __expf(tmp[j] - mx); tmp[j] = p; sum += p; }
        sum = wave_sum(sum);
        const float inv = 1.0f / sum;
        for (int j = lane; j <= i; j += 64) { if (c == 0) as[j] = tmp[j] * inv; else as[j] -= lam * tmp[j] * inv; }
    }
    LDS_WAIT(); asm volatile("" ::: "memory");
    float o0 = 0.f, o1 = 0.f, o2 = 0.f, o3 = 0.f;
    const bf16* vb = P + (size_t)(b * SEQ) * INC + 2048 + h * 256 + 4 * lane;
    for (int j = 0; j <= i; ++j) { const float a = as[j]; const v2u w = *(const v2u*)(vb + (size_t)j * INC);
        o0 += a * bflo(w.x); o1 += a * bfhi(w.x); o2 += a * bflo(w.y); o3 += a * bfhi(w.y); }
    const float ss = wave_sum(o0 * o0 + o1 * o1 + o2 * o2 + o3 * o3);
    const float r = 0.8f / sqrtf(ss * (1.0f / 256.0f) + NORM_EPS);
    const f32x4 g = *(const f32x4*)(subg + 4 * lane);
    v2u w; w.x = pk2(o0 * r * g.x, o1 * r * g.y); w.y = pk2(o2 * r * g.z, o3 * r * g.w);
    *(v2u*)(MIX + (size_t)(b * SEQ + i) * DM + h * 256 + 4 * lane) = w;
    LDS_WAIT(); asm volatile("" ::: "memory");
}
__device__ __forceinline__ void naive_ret_item(const bf16* P, bf16* MIX, int b, int h, int i, LAS float* scr, int lane) {
    const size_t rowq = (size_t)(b * SEQ + i) * INC;
    LAS float* qs = scr; LAS float* as = scr + 256;
    for (int t = lane; t < 128; t += 64) qs[t] = bf2f(P[rowq + 3072 + h * 128 + t]);
    LDS_WAIT(); asm volatile("" ::: "memory");
    const float lg = logf(1.0f - exp2f(-5.0f - (float)h)), scale = 0.08838834764831845f;
    for (int j = lane; j <= i; j += 64) {
        const bf16* kr = P + (size_t)(b * SEQ + j) * INC + 3584 + h * 128;
        const float s = dot_lds_bf16(qs, kr, 128);
        as[j] = s * scale * __expf(lg * (float)(i - j));
    }
    LDS_WAIT(); asm volatile("" ::: "memory");
    float o0 = 0.f, o1 = 0.f, o2 = 0.f, o3 = 0.f;
    const bf16* vb = P + (size_t)(b * SEQ) * INC + 4096 + h * 256 + 4 * lane;
    for (int j = 0; j <= i; ++j) { const float a = as[j]; const v2u w = *(const v2u*)(vb + (size_t)j * INC);
        o0 += a * bflo(w.x); o1 += a * bfhi(w.x); o2 += a * bflo(w.y); o3 += a * bfhi(w.y); }
    const float ss = wave_sum(o0 * o0 + o1 * o1 + o2 * o2 + o3 * o3);
    const float r = 1.0f / sqrtf(ss * (1.0f / 256.0f) + NORM_EPS);
    const v2u gw = *(const v2u*)(P + rowq + 5120 + h * 256 + 4 * lane);
    const float g0 = bflo(gw.x), g1 = bfhi(gw.x), g2 = bflo(gw.y), g3 = bfhi(gw.y);
    v2u w; w.x = pk2(o0 * r * (g0 / (1.0f + __expf(-g0))), o1 * r * (g1 / (1.0f + __expf(-g1)))); w.y = pk2(o2 * r * (g2 / (1.0f + __expf(-g2))), o3 * r * (g3 / (1.0f + __expf(-g3))));
    *(v2u*)(MIX + (size_t)(b * SEQ + i) * DM + 1024 + h * 256 + 4 * lane) = w;
    LDS_WAIT(); asm volatile("" ::: "memory");
}
__device__ __forceinline__ void naive_xattn_item(const bf16* XQ, const bf16* XKV, bf16* XO, int b, int h, int i, LAS float* scr, int lane) {
    const size_t rowq = (size_t)(b * SEQ + i) * DM + h * 512;
    LAS float* qs = scr; LAS float* as = scr + 512;
    for (int t = lane; t < 512; t += 64) qs[t] = bf2f(XQ[rowq + t]);
    LDS_WAIT(); asm volatile("" ::: "memory");
    const float scale = 0.044194173824159216f;
    float sc[4]; float mx = -3.0e38f;
#pragma unroll
    for (int t = 0; t < 4; ++t) { const int j = lane + 64 * t; sc[t] = dot_lds_bf16(qs, XKV + (size_t)(b * MEMLEN + j) * 4096 + h * 512, 512) * scale; mx = fmaxf(mx, sc[t]); }
    mx = wave_max(mx);
    float sum = 0.f;
#pragma unroll
    for (int t = 0; t < 4; ++t) { sc[t] = __expf(sc[t] - mx); sum += sc[t]; }
    sum = wave_sum(sum);
    const float inv = 1.0f / sum;
#pragma unroll
    for (int t = 0; t < 4; ++t) as[lane + 64 * t] = sc[t] * inv;
    LDS_WAIT(); asm volatile("" ::: "memory");
    float o[8];
#pragma unroll
    for (int e = 0; e < 8; ++e) o[e] = 0.f;
    const bf16* vb = XKV + (size_t)(b * MEMLEN) * 4096 + 2048 + h * 512 + 8 * lane;
    for (int j = 0; j < MEMLEN; ++j) { const float a = as[j]; const v4u w = *(const v4u*)(vb + (size_t)j * 4096);
        o[0] += a * bflo(w.x); o[1] += a * bfhi(w.x); o[2] += a * bflo(w.y); o[3] += a * bfhi(w.y); o[4] += a * bflo(w.z); o[5] += a * bfhi(w.z); o[6] += a * bflo(w.w); o[7] += a * bfhi(w.w); }
    v4u w; w.x = pk2(o[0], o[1]); w.y = pk2(o[2], o[3]); w.z = pk2(o[4], o[5]); w.w = pk2(o[6], o[7]);
    *(v4u*)(XO + rowq + 8 * lane) = w;
    LDS_WAIT(); asm volatile("" ::: "memory");
}


namespace att {
typedef short bf16x8 __attribute__((ext_vector_type(8)));
typedef short s16x4 __attribute__((ext_vector_type(4)));
typedef float f32x16 __attribute__((ext_vector_type(16)));
typedef unsigned u32x4 __attribute__((ext_vector_type(4)));
#define ATT_SBAR() __builtin_amdgcn_sched_barrier(0)
__device__ __forceinline__ int crow(int r, int hi) { return (r & 3) + 8 * (r >> 2) + 4 * hi; }
__device__ __forceinline__ unsigned cvtpk(float lo, float hi) { unsigned r; asm volatile("v_cvt_pk_bf16_f32 %0, %1, %2" : "=v"(r) : "v"(lo), "v"(hi)); return r; }
#define ATT_KSWZ(row, colB) ((row) * 256 + ((colB) ^ (((row) & 7) << 4)))
__device__ __forceinline__ int v_rd_base(int lane) { return ((lane & 3) << 3) | (((lane >> 2) & 3) << 6) | (((lane >> 4) & 1) << 5) | (((lane >> 5) & 1) << 8); }
__device__ __forceinline__ s16x4 vtr(const LAS unsigned char* p) { return __builtin_bit_cast(s16x4, __builtin_amdgcn_ds_read_tr16_b64_v4i16((LAS s16x4*)p)); }
#define ATT_PK4(P, BASE, OUT) do { unsigned a0_ = att::cvtpk(P[BASE + 0], P[BASE + 1]), a1_ = att::cvtpk(P[BASE + 2], P[BASE + 3]);   \
    unsigned b0_ = att::cvtpk(P[BASE + 4], P[BASE + 5]), b1_ = att::cvtpk(P[BASE + 6], P[BASE + 7]);                              \
    auto r0_ = __builtin_amdgcn_permlane32_swap(a0_, b0_, false, false); auto r1_ = __builtin_amdgcn_permlane32_swap(a1_, b1_, false, false); \
    att::u32x4 w_ = {r0_[0], r1_[0], r0_[1], r1_[1]}; OUT = __builtin_bit_cast(att::bf16x8, w_); } while (0)
__device__ __forceinline__ void glds16(const void* gsrc, LAS unsigned char* lds_dst) { __builtin_amdgcn_global_load_lds((const unsigned*)gsrc, (LAS unsigned*)lds_dst, 16, 0, 0); }
__device__ __forceinline__ void k_src(int n, int L, int& row, int& chunk) { row = 4 * n + (L >> 4); chunk = (L & 15) ^ (row & 7); }
template <int NCB> __device__ __forceinline__ void v_src(int n, int L, int& key, int& col) {
    const int off = n * 1024 + 16 * L, s = off >> 9, within = off & 511, kk7 = within >> 6, col8 = (within & 63) >> 1;
    const int kk = ((s / NCB) << 3) | kk7; key = (kk & ~0xC) | ((kk & 4) << 1) | ((kk & 8) >> 1); col = (s % NCB) * 32 + col8;
}
__device__ __forceinline__ float halfmax(float m) { auto rr = __builtin_amdgcn_permlane32_swap(__float_as_uint(m), __float_as_uint(m), false, false); return fmaxf(__uint_as_float(rr[0]), __uint_as_float(rr[1])); }
__device__ __forceinline__ float halfsum(float m) { auto rr = __builtin_amdgcn_permlane32_swap(__float_as_uint(m), __float_as_uint(m), false, false); return __uint_as_float(rr[0]) + __uint_as_float(rr[1]); }

__device__ __forceinline__ void stage_voffs(int lane, unsigned pitch, unsigned& vk0, unsigned& vk1, unsigned& vv) {
    vk0 = (unsigned)(lane >> 4) * pitch + (unsigned)(((lane & 15) ^ ((lane >> 4) & 7)) * 16);
    vk1 = (unsigned)(lane >> 4) * pitch + (unsigned)(((lane & 15) ^ ((4 + (lane >> 4)) & 7)) * 16);
    vv = (unsigned)(((lane >> 4) & 1) * 8 + ((lane >> 2) & 3)) * pitch + (unsigned)(((lane >> 5) * 32 + 8 * (lane & 3)) * 2);
}
__device__ __forceinline__ void xattn_stage(LAS unsigned char* buf, const bf16* XKV, int b, int h, int c, int wid, unsigned vk0, unsigned vk1, unsigned vv) {
    const char* base = (const char*)(XKV + (size_t)(b * MEMLEN) * 4096 + h * 512);
    if (c < 4) {
#pragma unroll
        for (int t = 0; t < 8; ++t) glds16(base + (size_t)((32 * wid + 4 * t) * 8192 + c * 256) + ((t & 1) ? vk1 : vk0), buf + (wid * 8 + t) * 1024);
    } else {
#pragma unroll
        for (int t = 0; t < 8; ++t) glds16(base + (size_t)((32 * wid + 16 * (t >> 2) + 4 * ((t >> 1) & 1)) * 8192 + (2048 + (c - 4) * 128 + 64 * (t & 1)) * 2) + vv, buf + (wid * 8 + t) * 1024);
    }
}
__device__ __forceinline__ void xattn_unit(LAS unsigned char* L, const bf16* XQ, const bf16* XKV, bf16* XO, int b, int h, int qb, const int wid) {
    const int lane = lane_id_fresh();
    const int r32 = lane & 31, hi = lane >> 5;
    const size_t row0 = (size_t)(b * SEQ + qb * 256 + wid * 32);
    const bf16* Qw = XQ + (row0 + r32) * DM + h * 512 + hi * 8;
    f32x16 p[8];
#pragma unroll
    for (int kb = 0; kb < 8; ++kb) p[kb] = f32x16{};
    bf16x8 qc[8];
#pragma unroll
    for (int d0 = 0; d0 < 8; ++d0) qc[d0] = *(const bf16x8*)(Qw + d0 * 16);
    unsigned vk0, vk1, vv; stage_voffs(lane, 8192u, vk0, vk1, vv);
    xattn_stage(L, XKV, b, h, 0, wid, vk0, vk1, vv);
    asm volatile("s_waitcnt vmcnt(0)" ::: "memory"); __syncthreads();
#pragma unroll 1
    for (int c = 0; c < 4; ++c) {
        LAS unsigned char* cur = L + (c & 1) * 65536; LAS unsigned char* nxt = L + ((c + 1) & 1) * 65536;
        xattn_stage(nxt, XKV, b, h, c + 1, wid, vk0, vk1, vv);
#pragma unroll
        for (int kb = 0; kb < 8; ++kb)
#pragma unroll
            for (int d0 = 0; d0 < 8; ++d0) { const int cb = (d0 * 16 + hi * 8) * 2;
                const bf16x8 kf = *(const LAS bf16x8*)(cur + ATT_KSWZ(kb * 32 + r32, cb));
                p[kb] = __builtin_amdgcn_mfma_f32_32x32x16_bf16(kf, qc[d0], p[kb], 0, 0, 0); }
        if (c < 3) {
#pragma unroll
            for (int d0 = 0; d0 < 8; ++d0) qc[d0] = *(const bf16x8*)(Qw + (c + 1) * 128 + d0 * 16);
        }
        asm volatile("s_waitcnt vmcnt(0)" ::: "memory"); __syncthreads();
    }
    constexpr float C = 0.044194173824159216f * 1.4426950408889634f;
    float mx = -3.0e38f;
#pragma unroll
    for (int kb = 0; kb < 8; ++kb)
#pragma unroll
        for (int r = 0; r < 16; ++r) mx = fmaxf(mx, p[kb][r]);
    mx = halfmax(mx);
    const float mC = -mx * C; float sum = 0.f;
#pragma unroll
    for (int kb = 0; kb < 8; ++kb)
#pragma unroll
        for (int r = 0; r < 16; ++r) { p[kb][r] = __builtin_amdgcn_exp2f(fmaf(p[kb][r], C, mC)); sum += p[kb][r]; }
    sum = halfsum(sum);
    const float inv = 1.0f / sum;
    bf16x8 pa[16];
#pragma unroll
    for (int kb = 0; kb < 8; ++kb) {
#pragma unroll
        for (int r = 0; r < 16; ++r) p[kb][r] *= inv;
        ATT_PK4(p[kb], 0, pa[2 * kb]); ATT_PK4(p[kb], 8, pa[2 * kb + 1]);
    }
    const int vb = v_rd_base(lane);
#pragma unroll 1
    for (int c = 4; c < 8; ++c) {
        LAS unsigned char* cur = L + (c & 1) * 65536; LAS unsigned char* nxt = L + ((c + 1) & 1) * 65536;
        if (c < 7) xattn_stage(nxt, XKV, b, h, c + 1, wid, vk0, vk1, vv);
        f32x16 o[4];
#pragma unroll
        for (int d0 = 0; d0 < 4; ++d0) { o[d0] = f32x16{};
#pragma unroll
            for (int ks = 0; ks < 16; ++ks) {
                const s16x4 lo = vtr(cur + vb + d0 * 512 + ks * 4096), hh = vtr(cur + vb + d0 * 512 + ks * 4096 + 2048);
                const bf16x8 vf = {lo[0], lo[1], lo[2], lo[3], hh[0], hh[1], hh[2], hh[3]};
                o[d0] = __builtin_amdgcn_mfma_f32_32x32x16_bf16(pa[ks], vf, o[d0], 0, 0, 0); } }
        bf16* Ow = XO + row0 * DM + h * 512 + (c - 4) * 128 + r32;
#pragma unroll
        for (int r = 0; r < 16; ++r)
#pragma unroll
            for (int d0 = 0; d0 < 4; ++d0) Ow[(size_t)crow(r, hi) * DM + d0 * 32] = (bf16)f2bf(o[d0][r]);
        asm volatile("s_waitcnt vmcnt(0)" ::: "memory"); __syncthreads();
    }
}

template <int MODE> __device__ __forceinline__ void causal_stage(LAS unsigned char* buf, const bf16* PROJ, int b, int h, int j, int wid, unsigned vk0, unsigned vk1, unsigned vv) {
    const char* base = (const char*)(PROJ + (size_t)(b * SEQ + 64 * j) * INC);
#pragma unroll
    for (int t = 0; t < 2; ++t) { const int n = 2 * wid + t; const size_t ro = (size_t)(8 * wid + 4 * t) * (INC * 2); const unsigned vk = t ? vk1 : vk0;
        if (MODE == 0) { glds16(base + ro + (1024 + h * 256) * 2 + vk, buf + n * 1024); glds16(base + ro + (1024 + h * 256 + 128) * 2 + vk, buf + 16384 + n * 1024); }
        else glds16(base + ro + (3584 + h * 128) * 2 + vk, buf + n * 1024); }
#pragma unroll
    for (int t = 0; t < 4; ++t) { const int n = 4 * wid + t;
        glds16(base + (size_t)((wid >> 1) * 16 + (wid & 1) * 4) * (INC * 2) + ((MODE == 0 ? 2048 : 4096) + h * 256 + 64 * t) * 2 + vv, buf + (MODE == 0 ? 32768 : 16384) + n * 1024); }
}
template <int MODE> __device__ __forceinline__ void causal_unit(LAS unsigned char* L, const bf16* PROJ, bf16* MIX, const float* subg, float lam, int b, int h, int i, const int wid) {
    constexpr int TILE_BYTES = MODE == 0 ? 65536 : 49152, V_OFF = MODE == 0 ? 32768 : 16384;
    constexpr float NEG = -1.0e30f, LOG2E = 1.4426950408889634f, C = 0.08838834764831845f * LOG2E;
    const int lane = lane_id_fresh();
    const int r32 = lane & 31, hi = lane >> 5;
    const int w4 = MODE == 0 ? (wid & 3) : wid, comp = MODE == 0 ? (wid >> 2) : 0;
    const int R0 = (MODE == 0 ? 128 : 256) * i + 32 * w4, NT = (MODE == 0 ? 2 : 4) * (i + 1), qpos = R0 + r32;
    const bf16* Qw = PROJ + (size_t)(b * SEQ + qpos) * INC + (MODE == 0 ? h * 256 + comp * 128 : 3072 + h * 128) + hi * 8;
    bf16x8 qr[8];
#pragma unroll
    for (int d0 = 0; d0 < 8; ++d0) qr[d0] = *(const bf16x8*)(Qw + d0 * 16);
    const float slope2 = __uint_as_float(__builtin_amdgcn_readfirstlane(__float_as_uint(MODE == 0 ? __builtin_amdgcn_exp2f(-2.0f * (float)(h + 1)) * LOG2E : -__builtin_amdgcn_logf(1.0f - __builtin_amdgcn_exp2f(-5.0f - (float)h)))));
    float m = NEG, l = 0.f; f32x16 o[8];
#pragma unroll
    for (int d0 = 0; d0 < 8; ++d0) o[d0] = f32x16{};
    LAS float* al = (LAS float*)(L + 131072 + 256 * wid); LAS float* li = al + 32;
    const int vb = v_rd_base(lane);
    unsigned vk0, vk1, vv; stage_voffs(lane, (unsigned)(INC * 2), vk0, vk1, vv);
    causal_stage<MODE>(L, PROJ, b, h, 0, wid, vk0, vk1, vv);
    asm volatile("s_waitcnt vmcnt(0)" ::: "memory"); __syncthreads();
#pragma unroll 1
    for (int j = 0; j < NT; ++j) {
        LAS unsigned char* cur = L + (j & 1) * TILE_BYTES; LAS unsigned char* nxt = L + ((j + 1) & 1) * TILE_BYTES;
        if (j + 1 < NT) causal_stage<MODE>(nxt, PROJ, b, h, j + 1, wid, vk0, vk1, vv);
        const LAS unsigned char* Kt = cur + comp * 16384; const LAS unsigned char* Vt = cur + V_OFF + vb;
#pragma unroll
        for (int hf = 0; hf < 2; ++hf) {
            const int k0 = 64 * j + 32 * hf;
            if (k0 <= R0 + 31) {
                f32x16 p = f32x16{};
                int kx = (r32 & 7) << 4; asm volatile("" : "+v"(kx));
                const LAS unsigned char* Kr = Kt + (32 * hf + r32) * 256;
#pragma unroll
                for (int d0 = 0; d0 < 8; ++d0) { const int cb = (d0 * 16 + hi * 8) * 2;
                    const bf16x8 kf = *(const LAS bf16x8*)(Kr + (cb ^ kx));
                    p = __builtin_amdgcn_mfma_f32_32x32x16_bf16(kf, qr[d0], p, 0, 0, 0); }
                const bool diag = k0 + 31 > R0;
                const float tb = slope2 * (float)(k0 + 4 * hi - qpos);
                if (MODE == 0) {
#pragma unroll
                    for (int r = 0; r < 16; ++r) p[r] = fmaf(p[r], C, tb + slope2 * (float)((r & 3) + 8 * (r >> 2)));
                    if (diag) {
#pragma unroll
                        for (int r = 0; r < 16; ++r) if (k0 + crow(r, hi) > qpos) p[r] = NEG;
                    }
                    float pmax = p[0];
#pragma unroll
                    for (int r = 1; r < 16; ++r) pmax = fmaxf(pmax, p[r]);
                    pmax = halfmax(pmax);
                    const float mn = fmaxf(m, pmax), alpha = __builtin_amdgcn_exp2f(m - mn); m = mn;
                    float ps = 0.f;
#pragma unroll
                    for (int r = 0; r < 16; ++r) { p[r] = __builtin_amdgcn_exp2f(p[r] - mn); ps += p[r]; }
                    l = l * alpha + ps;
                    if (__any(alpha < 1.0f)) {
                        if (hi == 0) al[r32] = alpha;
                        asm volatile("s_waitcnt lgkmcnt(0)" ::: "memory");
#pragma unroll
                        for (int r = 0; r < 16; ++r) { const float a = al[crow(r, hi)];
#pragma unroll
                            for (int d0 = 0; d0 < 8; ++d0) o[d0][r] *= a; }
                    }
                } else {
#pragma unroll
                    for (int r = 0; r < 16; ++r) p[r] = p[r] * 0.08838834764831845f * __builtin_amdgcn_exp2f(tb + slope2 * (float)((r & 3) + 8 * (r >> 2)));
                    if (diag) {
#pragma unroll
                        for (int r = 0; r < 16; ++r) if (k0 + crow(r, hi) > qpos) p[r] = 0.f;
                    }
                }
                bf16x8 pa0, pa1;
                ATT_PK4(p, 0, pa0); ATT_PK4(p, 8, pa1);
#pragma unroll
                for (int d0 = 0; d0 < 8; ++d0) {
#define ATT_VF(ks) ({ const s16x4 lo_ = vtr(Vt + d0 * 512 + (ks) * 8192), hh_ = vtr(Vt + d0 * 512 + (ks) * 8192 + 4096); (bf16x8){lo_[0], lo_[1], lo_[2], lo_[3], hh_[0], hh_[1], hh_[2], hh_[3]}; })
                    const bf16x8 v0 = ATT_VF(2 * hf), v1 = ATT_VF(2 * hf + 1);
#undef ATT_VF
                    o[d0] = __builtin_amdgcn_mfma_f32_32x32x16_bf16(pa0, v0, o[d0], 0, 0, 0);
                    o[d0] = __builtin_amdgcn_mfma_f32_32x32x16_bf16(pa1, v1, o[d0], 0, 0, 0); }
            }
        }
        asm volatile("s_waitcnt vmcnt(0)" ::: "memory"); __syncthreads();
    }
    float sc[16];
    if (MODE == 0) {
        l = halfsum(l);
        float lamv = lam; asm volatile("" : "+v"(lamv));
        if (hi == 0) li[r32] = (comp == 0 ? 1.0f : lamv + 0.2f) / l;
        asm volatile("s_waitcnt lgkmcnt(0)" ::: "memory");
#pragma unroll
        for (int r = 0; r < 16; ++r) sc[r] = li[crow(r, hi)];
        LAS float* EX = (LAS float*)L + (size_t)(w4 * 32) * 256 + r32;
        if (comp == 1) {
#pragma unroll
            for (int r = 0; r < 16; ++r)
#pragma unroll
                for (int d0 = 0; d0 < 8; ++d0) EX[crow(r, hi) * 256 + d0 * 32] = o[d0][r] * sc[r];
        }
        asm volatile("s_waitcnt lgkmcnt(0)" ::: "memory"); __syncthreads();
        if (comp == 0) {
#pragma unroll
            for (int r = 0; r < 16; ++r)
#pragma unroll
                for (int d0 = 0; d0 < 8; ++d0) o[d0][r] = o[d0][r] * sc[r] - EX[crow(r, hi) * 256 + d0 * 32];
        }
    }
    if (MODE == 1 || comp == 0) {
#pragma unroll
        for (int r = 0; r < 16; ++r) { float s = 0.f;
#pragma unroll
            for (int d0 = 0; d0 < 8; ++d0) s += o[d0][r] * o[d0][r];
            s += swz_xor<1>(s); s += swz_xor<2>(s); s += swz_xor<4>(s); s += swz_xor<8>(s); s += swz_xor<16>(s);
            sc[r] = (MODE == 0 ? 0.8f : 1.0f) / sqrtf(s * (1.0f / 256.0f) + NORM_EPS); }
        const size_t orow = (size_t)(b * SEQ + R0);
        if (MODE == 0) {
            float g[8];
#pragma unroll
            for (int d0 = 0; d0 < 8; ++d0) g[d0] = subg[d0 * 32 + r32];
            bf16* Ow = MIX + orow * DM + h * 256 + r32;
#pragma unroll
            for (int r = 0; r < 16; ++r)
#pragma unroll
                for (int d0 = 0; d0 < 8; ++d0) Ow[(size_t)crow(r, hi) * DM + d0 * 32] = (bf16)f2bf(o[d0][r] * sc[r] * g[d0]);
        } else {
            bf16* Ow = MIX + orow * DM + 1024 + h * 256 + r32; const bf16* Gw = PROJ + orow * INC + 5120 + h * 256 + r32;
#pragma unroll
            for (int r = 0; r < 16; ++r)
#pragma unroll
                for (int d0 = 0; d0 < 8; ++d0) { const float gt = bf2f(Gw[(size_t)crow(r, hi) * INC + d0 * 32]);
                    Ow[(size_t)crow(r, hi) * DM + d0 * 32] = (bf16)f2bf(o[d0][r] * sc[r] * (gt * __builtin_amdgcn_rcpf(1.0f + __builtin_amdgcn_exp2f(-LOG2E * gt)))); }
        }
    }
}
__device__ __forceinline__ int p2_class(int k) { const unsigned long long T0 = 0x3d509b2aeb635cfULL, T1 = 0x403110e44994d4ULL; return (int)(((k < 12 ? T0 : T1) >> (5 * (k < 12 ? k : k - 12))) & 31ULL); }
}
#ifndef PROBE_P1
#define PROBE_P1 1
#endif
#ifndef PROBE_P3
#define PROBE_P3 1
#endif
#ifndef PROBE_P0
#define PROBE_P0 1
#endif
#ifndef PROBE_P2
#define PROBE_P2 1
#endif
#ifndef PROBE_P4
#define PROBE_P4 1
#endif
#ifndef PROBE_P5
#define PROBE_P5 1
#endif
#ifndef PROBE_P7
#define PROBE_P7 1
#endif
struct Args { const float* in[21]; float* out; unsigned char* ws; };
__global__ void __launch_bounds__(NWAVES * 64, 2) mega_fwd(Args args) {
    extern __shared__ __attribute__((aligned(16))) unsigned char lds[];
    LAS unsigned char* L = (LAS unsigned char*)lds;
    volatile LAS unsigned* MISC = (volatile LAS unsigned*)(L + MISC_OFF);
    const int wave = __builtin_amdgcn_readfirstlane((int)threadIdx.x >> 6);
#define MY_LANE() lane_id_fresh()
    const int G = gridDim.x; const int bx = blockIdx.x; const int vcu = (G % 8 == 0) ? (bx % 8) * (G / 8) + bx / 8 : bx;
    unsigned char* ws = args.ws;
    gu32* ctl = (gu32*)(ws + WS_CTL);
    const float* x = args.in[0]; const float* mem = args.in[1];
    float* out = args.out;
    bf16* Win_t = (bf16*)(ws + WS_WIN); bf16* Wo_t = (bf16*)(ws + WS_WO); bf16* Wxq_t = (bf16*)(ws + WS_WXQ); bf16* Wxkv_t = (bf16*)(ws + WS_WXKV);
    bf16* Wxo_t = (bf16*)(ws + WS_WXO); bf16* Wgu_t = (bf16*)(ws + WS_WGU); bf16* Wd_t = (bf16*)(ws + WS_WD);
    bf16* HM = (bf16*)(ws + WS_HM); bf16* XKV = (bf16*)(ws + WS_XKV); bf16* XB = (bf16*)(ws + WS_B); bf16* MIX = (bf16*)(ws + WS_C);
    bf16* PROJ = (bf16*)(ws + WS_A); bf16* XQ = (bf16*)(ws + WS_A); bf16* XO = (bf16*)(ws + WS_A + 32 * MiB); bf16* HFF = (bf16*)(ws + WS_A);
    float* ssq1 = (float*)(ws + WS_SSQ); float* ssq2 = ssq1 + MTOK; float* ssq3 = ssq2 + MTOK;
    for (int u = (int)threadIdx.x; u < (LDS_BYTES - LDSCTL_OFF) / 4; u += NWAVES * 64) ((LAS unsigned*)(L + LDSCTL_OFF))[u] = 0u;
    __syncthreads();
    XcdBarrier bar = xcd_barrier_post((unsigned*)(ctl + CW_BAR), MISC + 8);
    const int gw = vcu * NWAVES + wave, NGW = G * NWAVES;

    for (int rep_ = 0; rep_ < PROBE_P0; ++rep_) {
        LAS float* scr = (LAS float*)(L + RING_OFF + wave * 16384);
        const int lane = MY_LANE(), tid = wave * 64 + lane;
        constexpr int I_IN = (DM / 64) * (INC / 32), I_SQ = (DM / 64) * (DM / 32), I_FF = (DM / 64) * (DFF / 32), I_DN = (DFF / 64) * (DM / 32);
        constexpr int NITEMS = I_IN + 5 * I_SQ;
        for (int it = gw; it < NITEMS; it += NGW) {
            int r = it;
            if (r < I_IN) { p0_transpose_item(args.in[3], DM, INC, Win_t, 0, 0, nullptr, scr, r, lane); continue; } r -= I_IN;
            if (r < I_SQ) { p0_transpose_item(args.in[9], DM, DM, Wo_t, 0, 0, nullptr, scr, r, lane); continue; } r -= I_SQ;
            if (r < I_SQ) { p0_transpose_item(args.in[12], DM, DM, Wxq_t, 0, 0, args.in[10], scr, r, lane); continue; } r -= I_SQ;
            if (r < I_SQ) { p0_transpose_item(args.in[13], DM, DM, Wxkv_t, 0, 0, nullptr, scr, r, lane); continue; } r -= I_SQ;
            if (r < I_SQ) { p0_transpose_item(args.in[14], DM, DM, Wxkv_t, 0, DM, nullptr, scr, r, lane); continue; } r -= I_SQ;
            p0_transpose_item(args.in[15], DM, DM, Wxo_t, 0, 0, nullptr, scr, r, lane);
        }
        for (int m = gw; m < MTOK; m += NGW) rms_row_to_bf16(x + (size_t)m * DM, args.in[2], XB + (size_t)m * DM, lane);
        for (int m = gw; m < MMEM; m += NGW) rms_row_to_bf16(mem + (size_t)m * DM, args.in[11], HM + (size_t)m * DM, lane);
        for (int i = bx * (NWAVES * 64) + tid; i < 3 * MTOK; i += G * NWAVES * 64) ssq1[i] = 0.f;
    }
    xcd_barrier(bar);

    for (int rep_ = 0; rep_ < PROBE_P1; ++rep_) {
        pg8::Gemm g{XB, Win_t, MTOK, INC, DM}; pg8::StaticOrder S; S.init(MTOK, INC, G, bx);
        pg8::EpiBf16 E{PROJ, INC};
        pg8::gemm_phase<pg8::EpiBf16, pg8::StaticOrder, true, true>(L + RING_OFF, g, S, E, wave);
    }
    xcd_barrier(bar);

    {
        float lam;
        { int l2 = MY_LANE(); asm volatile("" : "+v"(l2));
          const float a1 = args.in[4][l2] * args.in[5][l2] + args.in[4][l2 + 64] * args.in[5][l2 + 64];
          const float a2 = args.in[6][l2] * args.in[7][l2] + args.in[6][l2 + 64] * args.in[7][l2 + 64];
          lam = __uint_as_float(__builtin_amdgcn_readfirstlane(__float_as_uint(__expf(wave_sum(a1)) - __expf(wave_sum(a2))))); }
        for (int rep_ = 0; rep_ < PROBE_P2; ++rep_)
        for (;;) {
            __syncthreads();
            unsigned qa = MISC_OFF; asm volatile("" : "+v"(qa));
            if (wave == 0 && MY_LANE() == 0) *(volatile LAS unsigned*)(L + qa) = __hip_atomic_fetch_add((unsigned*)(ctl + CW_Q + 64 * rep_), 1u, __ATOMIC_RELAXED, __HIP_MEMORY_SCOPE_AGENT);
            __syncthreads();
            const int u0 = __builtin_amdgcn_readfirstlane((int)*(volatile LAS unsigned*)(L + qa));
            if (u0 >= 64 + 384) break;
            if (u0 < 64) {
                pg8::Gemm g{HM, Wxkv_t, MMEM, 2 * DM, DM}; pg8::OneUnit S{u0 & 3, u0 >> 2};
                pg8::EpiBf16 E{XKV, 2 * DM};
                pg8::gemm_phase<pg8::EpiBf16, pg8::OneUnit, true, true>(L + RING_OFF, g, S, E, wave);
                continue;
            }
            const int u = u0 - 64;
            const int cls = att::p2_class(u >> 4), bh = u & 15;
            if (cls < 16) att::causal_unit<0>(L, PROJ, MIX, args.in[8], lam, bh >> 2, bh & 3, cls, wave);
            else att::causal_unit<1>(L, PROJ, MIX, nullptr, 0.f, bh >> 2, bh & 3, cls - 16, wave);
        }
    }
    xcd_barrier(bar);

    for (int rep_ = 0; rep_ < PROBE_P3; ++rep_) {
        pg8::Gemm g{MIX, Wo_t, MTOK, DM, DM}; pg8::StaticOrder S; S.init(MTOK, DM, G, bx);
        pg8::EpiResB<true> E{x, nullptr, XB, rep_ == 0 ? ssq1 : ssq1 + 3 * MTOK, DM};
        pg8::gemm_phase<pg8::EpiResB<true>, pg8::StaticOrder, true, true>(L + RING_OFF, g, S, E, wave);
    }
    xcd_barrier(bar);

    for (int rep_ = 0; rep_ < PROBE_P4; ++rep_) {
        pg8::Gemm g{XB, Wxq_t, MTOK, DM, DM}; pg8::StaticOrder S; S.init(MTOK, DM, G, bx);
        pg8::EpiScaleBf16 E{XQ, DM, ssq1};
        pg8::gemm_phase<pg8::EpiScaleBf16, pg8::StaticOrder, true, true>(L + RING_OFF, g, S, E, wave);
    }
    xcd_barrier(bar);

    {
        for (int rep_ = 0; rep_ < PROBE_P5; ++rep_)
        if ((vcu & 1) == 0) { const int u = vcu >> 1, bh = u >> 3; att::xattn_unit(L, XQ, XKV, XO, bh >> 2, bh & 3, u & 7, wave); }
        else {
            LAS float* scr = (LAS float*)(L + RING_OFF + wave * 16384); const int lane = MY_LANE();
            constexpr int I_FF = (DM / 64) * (DFF / 32);
            for (int it = (vcu >> 1) * NWAVES + wave; it < 2 * I_FF; it += (G / 2) * NWAVES) {
                if (it < I_FF) p0_transpose_item(args.in[17], DM, DFF, Wgu_t, 1, 0, args.in[16], scr, it, lane);
                else p0_transpose_item(args.in[18], DM, DFF, Wgu_t, 2, 0, args.in[16], scr, it - I_FF, lane);
            }
        }
    }
    xcd_barrier(bar);

    {
        pg8::Gemm g{XO, Wxo_t, MTOK, DM, DM}; pg8::StaticOrder S; S.init(MTOK, DM, G, bx);
        pg8::EpiResB<false> E{nullptr, XB, XB, ssq2, DM};
        pg8::gemm_phase<pg8::EpiResB<false>, pg8::StaticOrder, true, true>(L + RING_OFF, g, S, E, wave);
    }
    xcd_barrier(bar);

    for (int rep_ = 0; rep_ < PROBE_P7; ++rep_) {
        pg8::Gemm g{XB, Wgu_t, MTOK, 2 * DFF, DM}; pg8::StaticOrder S; S.init(MTOK, 2 * DFF, G, bx);
        pg8::EpiSwiGLU E{HFF, DFF, ssq2};
        pg8::gemm_phase<pg8::EpiSwiGLU, pg8::StaticOrder, true, true>(L + RING_OFF, g, S, E, wave);
        if (rep_ == 0 && bx >= 128) {
            LAS float* scr = (LAS float*)(L + RING_OFF + wave * 16384); const int lane = MY_LANE();
            constexpr int I_DN = (DFF / 64) * (DM / 32);
            for (int it = (bx - 128) * NWAVES + wave; it < I_DN; it += 128 * NWAVES) p0_transpose_item(args.in[19], DFF, DM, Wd_t, 0, 0, nullptr, scr, it, lane);
        }
    }
    xcd_barrier(bar);

    {
        pg8::Gemm g{HFF, Wd_t, MTOK, DM, DFF}; pg8::StaticOrder S; S.init(MTOK, DM, G, bx);
        pg8::EpiResB<false> E{nullptr, XB, XB, ssq3, DM};
        pg8::gemm_phase<pg8::EpiResB<false>, pg8::StaticOrder, true, true>(L + RING_OFF, g, S, E, wave);
    }
    xcd_barrier(bar);

    int lane9 = MY_LANE(); asm volatile("" : "+v"(lane9));
    for (int m = gw; m < MTOK; m += NGW) {
        const float r = 1.0f / sqrtf(ssq3[m] * (1.0f / DM) + NORM_EPS);
        const v4u* xr = (const v4u*)(XB + (size_t)m * DM) + lane9; f32x4* orow = (f32x4*)(out + (size_t)m * DM) + 2 * lane9; const f32x4* gr = (const f32x4*)args.in[20] + 2 * lane9;
#pragma unroll
        for (int j = 0; j < 4; ++j) { const v4u w = xr[64 * j]; const f32x4 g0 = gr[128 * j], g1 = gr[128 * j + 1];
            orow[128 * j] = (f32x4){bflo(w.x), bfhi(w.x), bflo(w.y), bfhi(w.y)} * r * g0; orow[128 * j + 1] = (f32x4){bflo(w.z), bfhi(w.z), bflo(w.w), bfhi(w.w)} * r * g1; }
    }
}

extern "C" void kernel_launch(void* const* d_in, const int* in_sizes, int n_in, void* d_out, int out_size, void* d_ws, size_t ws_size, hipStream_t stream) {
    static int grid = 0;
    if (grid == 0) {
        if (n_in != 21 || in_sizes[0] != MTOK * DM || out_size != MTOK * DM || ws_size < WS_END) { fprintf(stderr, "kernel_launch: unexpected shapes / workspace (n_in %d, ws %zu)\n", n_in, ws_size); grid = -1; return; }
        int dev = 0, cus = 0, per_cu = 0;
        if (hipGetDevice(&dev) != hipSuccess || hipDeviceGetAttribute(&cus, hipDeviceAttributeMultiprocessorCount, dev) != hipSuccess) { grid = -1; return; }
        if (hipFuncSetAttribute((const void*)mega_fwd, hipFuncAttributeMaxDynamicSharedMemorySize, LDS_BYTES) != hipSuccess) { fprintf(stderr, "kernel_launch: hipFuncSetAttribute failed\n"); grid = -1; return; }
        if (hipOccupancyMaxActiveBlocksPerMultiprocessor(&per_cu, (const void*)mega_fwd, NWAVES * 64, LDS_BYTES) != hipSuccess || per_cu < 1) { fprintf(stderr, "kernel_launch: occupancy query reports %d blocks per CU\n", per_cu); (void)hipGetLastError(); grid = -1; return; }
        grid = cus;
    }
    if (grid < 0) return;
    if (hipMemsetAsync((char*)d_ws + WS_CTL, 0, CTL_ZERO_BYTES, stream) != hipSuccess) return;
    Args a{};
    for (int i = 0; i < 21; ++i) a.in[i] = (const float*)d_in[i];
    a.out = (float*)d_out; a.ws = (unsigned char*)d_ws;
    hipLaunchKernelGGL(mega_fwd, dim3(grid), dim3(NWAVES * 64), LDS_BYTES, stream, a);
}
```

```cpp
#include <hip/hip_runtime.h>
#include <cstdio>
#include <cstdint>
namespace pg8 {
#define PG8_LAS __attribute__((address_space(3)))
typedef unsigned short bf16_t;
typedef short bf16x8 __attribute__((ext_vector_type(8)));
typedef float f32x4 __attribute__((ext_vector_type(4)));
typedef unsigned u32x4 __attribute__((ext_vector_type(4)));
constexpr int BM = 256, BK = 64, HALF = 128, HTB = HALF * BK * 2  , STAGE_BYTES = 8 * HTB, NXCD = 8, WGM = 8;

__host__ __device__ __forceinline__ int lds_byte(int r, int c) { const int st = (r >> 4) * 2 + (c >> 5), rr = r & 15, cc = c & 31, ob = rr * 64 + cc * 2; return st * 1024 + (ob ^ (((ob >> 9) & 1) << 5)); }
__host__ __device__ __forceinline__ void stage_rc(int b, int& R, int& C) { const int st = b / 1024, sb = b % 1024, swz = sb ^ (((sb >> 9) & 1) << 5); R = (st >> 1) * 16 + swz / 64; C = (st & 1) * 32 + (swz % 64) / 2; }
__host__ __device__ __forceinline__ int perm32(int rho) { const int n = rho >> 4, i = rho & 15; return 8 * (i >> 2) + 4 * n + (i & 3); }

struct Unit { int pm, pn; };
struct Gemm { const bf16_t* A; const bf16_t* Bt; int M, N, K; };

struct StaticOrder {
    int nM, nN, nwg, G, c;
    __host__ __device__ void init(int M, int N, int G_, int c_) { nM = M / BM; nN = N / BM; nwg = nM * nN; G = G_; c = c_; }
    __host__ __device__ bool next(int i, Unit& u) const {
        const long L = (long)i * G + c; if (L >= nwg) return false;
        int wgid = (int)L; { const int q = nwg / NXCD, r = nwg % NXCD, xcd = wgid % NXCD, off = wgid / NXCD; wgid = (xcd < r ? xcd * (q + 1) : r * (q + 1) + (xcd - r) * q) + off; }
        const int nig = WGM * nN, gid = wgid / nig, fm = gid * WGM, gsz = (nM - fm) < WGM ? (nM - fm) : WGM;
        u.pm = fm + ((wgid % nig) % gsz); u.pn = (wgid % nig) / gsz; return true;
    }
    __device__ __forceinline__ void a_ready(const Unit&) const {}
    __device__ __forceinline__ void done(const Unit&) const {}
};

__device__ __forceinline__ unsigned cvt_pk_bf16(float lo, float hi) { unsigned r; asm volatile("v_cvt_pk_bf16_f32 %0, %1, %2" : "=v"(r) : "v"(lo), "v"(hi)); return r; }
typedef float f32x2 __attribute__((ext_vector_type(2)));
struct OneUnit { int pm, pn;
    __device__ __forceinline__ bool next(int i, Unit& u) const { if (i != 0) return false; u.pm = pm; u.pn = pn; return true; }
    __device__ __forceinline__ void a_ready(const Unit&) const {}
    __device__ __forceinline__ void done(const Unit&) const {}
};
typedef unsigned u32x2 __attribute__((ext_vector_type(2)));
struct EpiBf16 {
    static constexpr bool PERM = true, AFTER_DRAIN = false;
    bf16_t* O; int ldc;
    __device__ __forceinline__ void operator()(const f32x4 (&acc)[2][2][4][2], const Unit& u, int wr, int wc, int fr, int fq) const {
        const int row0 = u.pm * BM + wr * 64 + fr, col0 = u.pn * BM + wc * 32 + 8 * fq;
#pragma unroll
        for (int ai = 0; ai < 2; ++ai)
#pragma unroll
            for (int m = 0; m < 4; ++m) { bf16_t* rowp = O + (size_t)(row0 + ai * HALF + m * 16) * ldc + col0;
#pragma unroll
                for (int bj = 0; bj < 2; ++bj) { const f32x4 v0 = acc[ai][bj][m][0], v1 = acc[ai][bj][m][1];
                    u32x4 w; w.x = cvt_pk_bf16(v0[0], v0[1]); w.y = cvt_pk_bf16(v0[2], v0[3]); w.z = cvt_pk_bf16(v1[0], v1[1]); w.w = cvt_pk_bf16(v1[2], v1[3]);
                    *(u32x4*)(rowp + bj * HALF) = w; } }
    }
};
struct EpiScaleBf16 {
    static constexpr bool PERM = true, AFTER_DRAIN = false;
    bf16_t* O; int ldc; const float* ssq;
    __device__ __forceinline__ void operator()(const f32x4 (&acc)[2][2][4][2], const Unit& u, int wr, int wc, int fr, int fq) const {
        const int row0 = u.pm * BM + wr * 64 + fr, col0 = u.pn * BM + wc * 32 + 8 * fq;
#pragma unroll
        for (int ai = 0; ai < 2; ++ai)
#pragma unroll
            for (int m = 0; m < 4; ++m) { const int row = row0 + ai * HALF + m * 16; bf16_t* rowp = O + (size_t)row * ldc + col0;
                const float r = 1.0f / sqrtf(ssq[row] * (1.0f / 2048.0f) + 1e-6f);
#pragma unroll
                for (int bj = 0; bj < 2; ++bj) { const f32x4 v0 = acc[ai][bj][m][0] * r, v1 = acc[ai][bj][m][1] * r;
                    u32x4 w; w.x = cvt_pk_bf16(v0[0], v0[1]); w.y = cvt_pk_bf16(v0[2], v0[3]); w.z = cvt_pk_bf16(v1[0], v1[1]); w.w = cvt_pk_bf16(v1[2], v1[3]);
                    *(u32x4*)(rowp + bj * HALF) = w; } }
    }
};
__device__ __forceinline__ float silu_f(float g) { return g * __builtin_amdgcn_rcpf(1.0f + __builtin_amdgcn_exp2f(-1.4426950408889634f * g)); }
struct EpiSwiGLU {
    static constexpr bool PERM = true, AFTER_DRAIN = false;
    bf16_t* O; int ldc; const float* ssq;
    __device__ __forceinline__ void operator()(const f32x4 (&acc)[2][2][4][2], const Unit& u, int wr, int wc, int fr, int fq) const {
        const int row0 = u.pm * BM + wr * 64 + fr, col0 = u.pn * HALF + wc * 32 + 8 * fq;
#pragma unroll
        for (int ai = 0; ai < 2; ++ai)
#pragma unroll
            for (int m = 0; m < 4; ++m) { const int row = row0 + ai * HALF + m * 16; bf16_t* rowp = O + (size_t)row * ldc + col0;
                const float r = 1.0f / sqrtf(ssq[row] * (1.0f / 2048.0f) + 1e-6f);
                float h[8];
#pragma unroll
                for (int n = 0; n < 2; ++n)
#pragma unroll
                    for (int j = 0; j < 4; ++j) { const float g = acc[ai][0][m][n][j] * r, up = acc[ai][1][m][n][j] * r; h[n * 4 + j] = silu_f(g) * up; }
                u32x4 w; w.x = cvt_pk_bf16(h[0], h[1]); w.y = cvt_pk_bf16(h[2], h[3]); w.z = cvt_pk_bf16(h[4], h[5]); w.w = cvt_pk_bf16(h[6], h[7]);
                *(u32x4*)rowp = w; }
    }
};
struct EpiRes {
    static constexpr bool PERM = false, AFTER_DRAIN = false;
    const float* base; float* out; bf16_t* xb; float* ssq; int ldc;
    __device__ __forceinline__ void operator()(const f32x4 (&acc)[2][2][4][2], const Unit& u, int wr, int wc, int fr, int fq) const {
        const int row0 = u.pm * BM + wr * 64 + fr, col0 = u.pn * BM + wc * 32 + 4 * fq;
#pragma unroll
        for (int ai = 0; ai < 2; ++ai)
#pragma unroll
            for (int m = 0; m < 4; ++m) { const int row = row0 + ai * HALF + m * 16; const size_t off = (size_t)row * ldc + col0; float s = 0.f;
#pragma unroll
                for (int bj = 0; bj < 2; ++bj)
#pragma unroll
                    for (int n = 0; n < 2; ++n) { const size_t o2 = off + bj * HALF + n * 16; const f32x4 v = *(const f32x4*)(base + o2) + acc[ai][bj][m][n];
                        *(f32x4*)(out + o2) = v; s += (v[0] * v[0] + v[1] * v[1]) + (v[2] * v[2] + v[3] * v[3]);
                        if (xb) { u32x2 w; w.x = cvt_pk_bf16(v[0], v[1]); w.y = cvt_pk_bf16(v[2], v[3]); *(u32x2*)(xb + o2) = w; } }
                s += __int_as_float(__builtin_amdgcn_ds_swizzle(__float_as_int(s), (16 << 10) | 0x1f)); { auto rr = __builtin_amdgcn_permlane32_swap(__float_as_uint(s), __float_as_uint(s), false, false); s = __uint_as_float(rr[0]) + __uint_as_float(rr[1]); }
                if (fq == 0) atomicAdd(ssq + row, s);
                if (m & 1) asm volatile("" ::: "memory"); }
    }
};

template <bool BASE_F32> struct EpiResB {
    static constexpr bool PERM = true, AFTER_DRAIN = false;
    const float* basef; const bf16_t* baseb; bf16_t* xo; float* ssq; int ldc;
    __device__ __forceinline__ void operator()(const f32x4 (&acc)[2][2][4][2], const Unit& u, int wr, int wc, int fr, int fq) const {
        const int row0 = u.pm * BM + wr * 64 + fr, col0 = u.pn * BM + wc * 32 + 8 * fq;
#pragma unroll
        for (int ai = 0; ai < 2; ++ai)
#pragma unroll
            for (int m = 0; m < 4; ++m) { const int row = row0 + ai * HALF + m * 16; const size_t off = (size_t)row * ldc + col0; float s = 0.f;
#pragma unroll
                for (int bj = 0; bj < 2; ++bj) { const size_t o2 = off + bj * HALF; f32x4 b0, b1;
                    if (BASE_F32) { b0 = *(const f32x4*)(basef + o2); b1 = *(const f32x4*)(basef + o2 + 4); }
                    else { const u32x4 w = *(const u32x4*)(baseb + o2);
                        b0 = (f32x4){__uint_as_float(w.x << 16), __uint_as_float(w.x & 0xffff0000u), __uint_as_float(w.y << 16), __uint_as_float(w.y & 0xffff0000u)};
                        b1 = (f32x4){__uint_as_float(w.z << 16), __uint_as_float(w.z & 0xffff0000u), __uint_as_float(w.w << 16), __uint_as_float(w.w & 0xffff0000u)}; }
                    const f32x4 v0 = b0 + acc[ai][bj][m][0], v1 = b1 + acc[ai][bj][m][1];
                    s += ((v0[0] * v0[0] + v0[1] * v0[1]) + (v0[2] * v0[2] + v0[3] * v0[3])) + ((v1[0] * v1[0] + v1[1] * v1[1]) + (v1[2] * v1[2] + v1[3] * v1[3]));
                    u32x4 w; w.x = cvt_pk_bf16(v0[0], v0[1]); w.y = cvt_pk_bf16(v0[2], v0[3]); w.z = cvt_pk_bf16(v1[0], v1[1]); w.w = cvt_pk_bf16(v1[2], v1[3]);
                    *(u32x4*)(xo + o2) = w; }
                s += __int_as_float(__builtin_amdgcn_ds_swizzle(__float_as_int(s), (16 << 10) | 0x1f)); { auto rr = __builtin_amdgcn_permlane32_swap(__float_as_uint(s), __float_as_uint(s), false, false); s = __uint_as_float(rr[0]) + __uint_as_float(rr[1]); }
                if (fq == 0) atomicAdd(ssq + row, s);
                if (m & 1) asm volatile("" ::: "memory"); }
    }
};

struct EpiBf16Tiled {
    static constexpr bool PERM = true, AFTER_DRAIN = false;
    bf16_t* O; int M;
    __device__ __forceinline__ void operator()(const f32x4 (&acc)[2][2][4][2], const Unit& u, int wr, int wc, int fr, int fq) const {
        const int row0 = u.pm * BM + wr * 64 + fr, col0 = wc * 32 + 8 * fq;
        bf16_t* tb = O + (size_t)u.pn * ((size_t)M * BM);
#pragma unroll
        for (int ai = 0; ai < 2; ++ai)
#pragma unroll
            for (int m = 0; m < 4; ++m) { bf16_t* rowp = tb + (size_t)(row0 + ai * HALF + m * 16) * BM + col0;
#pragma unroll
                for (int bj = 0; bj < 2; ++bj) { const f32x4 v0 = acc[ai][bj][m][0], v1 = acc[ai][bj][m][1];
                    u32x4 w; w.x = cvt_pk_bf16(v0[0], v0[1]); w.y = cvt_pk_bf16(v0[2], v0[3]); w.z = cvt_pk_bf16(v1[0], v1[1]); w.w = cvt_pk_bf16(v1[2], v1[3]);
                    *(u32x4*)(rowp + bj * HALF) = w; } }
    }
};
template <class Epi, class Sched, bool ALIGN_EPI = false, bool SP2 = false>
__device__ __forceinline__ void gemm_phase(PG8_LAS unsigned char* lds, const Gemm g, const Sched& S, const Epi& E, const int wave_id) {
    int lane_; asm volatile("v_mbcnt_lo_u32_b32 %0, -1, 0\n\tv_mbcnt_hi_u32_b32 %0, -1, %0" : "=v"(lane_)); const int tid_ = wave_id * 64 + lane_;
    const int tid = tid_, wid = wave_id, lane = tid & 63, wr = wid >> 2, wc = wid & 3, fr = lane & 15, fq = lane >> 4;
    const int K = g.K, nt = K / BK;
    unsigned voffA[2], voffB[2];
#pragma unroll
    for (int i = 0; i < 2; ++i) { int R, C; stage_rc(tid * 16 + i * 8192, R, C); const int Rb = Epi::PERM ? ((R & ~31) + perm32(R & 31)) : R;
        voffA[i] = (unsigned)(R * K + C) * 2u; voffB[i] = (unsigned)(Rb * K + C) * 2u; }
    const size_t kstep = (size_t)(BK * 2);
    const size_t hstep = (size_t)HALF * K * 2;
    const size_t tstep = 2 * hstep;
    const unsigned ldsw = (unsigned)wid * 1024u;
    const int aoff = lds_byte(wr * 64 + fr, fq * 8), boff = lds_byte(wc * 32 + fr, fq * 8);
#define PG8_SA(b, h) (((b) * 2 + (h)) * HTB)
#define PG8_SB(b, h) ((4 + (b) * 2 + (h)) * HTB)
#define PG8_STAGE(bufoff, gbase, voff) do { _Pragma("unroll") for (int _i = 0; _i < 2; ++_i) \
        __builtin_amdgcn_global_load_lds((const unsigned*)((const char*)(gbase) + (voff)[_i]), (PG8_LAS unsigned*)(lds + (bufoff) + ldsw + _i * 8192), 16, 0, 0); } while (0)
#define PG8_LDA(dst, b, h) do { _Pragma("unroll") for (int m = 0; m < 4; ++m) _Pragma("unroll") for (int k = 0; k < 2; ++k) dst[m][k] = *(const PG8_LAS bf16x8*)(lds + PG8_SA(b, h) + aoff + m * 2048 + k * 1024); } while (0)
#define PG8_LDB(dst, b, h) do { _Pragma("unroll") for (int n = 0; n < 2; ++n) _Pragma("unroll") for (int k = 0; k < 2; ++k) dst[n][k] = *(const PG8_LAS bf16x8*)(lds + PG8_SB(b, h) + boff + n * 2048 + k * 1024); } while (0)
#define PG8_MMA(ai, bj, At, Bt) do { __builtin_amdgcn_s_setprio(1); _Pragma("unroll") for (int m = 0; m < 4; ++m) _Pragma("unroll") for (int n = 0; n < 2; ++n) _Pragma("unroll") for (int k = 0; k < 2; ++k) \
        acc[ai][bj][m][n] = __builtin_amdgcn_mfma_f32_16x16x32_bf16(Bt[n][k], At[m][k], acc[ai][bj][m][n], 0, 0, 0); __builtin_amdgcn_s_setprio(0); } while (0)
#define PG8_WAIT_V(n) asm volatile("s_waitcnt vmcnt(" #n ")" ::: "memory")
#define PG8_WAIT_L(n) asm volatile("s_waitcnt lgkmcnt(" #n ")" ::: "memory")
#define PG8_BAR __builtin_amdgcn_s_barrier()
#define PG8_SCHED __builtin_amdgcn_sched_barrier(0)
    Unit cur, nxt; int ui = 0;
    if (!S.next(0, cur)) return;
    f32x4 acc[2][2][4][2];
#pragma unroll
    for (int a = 0; a < 2; ++a)
#pragma unroll
        for (int b = 0; b < 2; ++b)
#pragma unroll
            for (int m = 0; m < 4; ++m)
#pragma unroll
                for (int n = 0; n < 2; ++n) acc[a][b][m][n] = (f32x4){0.f, 0.f, 0.f, 0.f};
    bf16x8 At[4][2], B0[2][2], B1[2][2];
    const char* cA = (const char*)g.A + (size_t)cur.pm * tstep; const char* cB = (const char*)g.Bt + (size_t)cur.pn * tstep;
    S.a_ready(cur);
    if constexpr (SP2) {
        PG8_STAGE(PG8_SB(0, 0), cB, voffB); PG8_STAGE(PG8_SB(0, 1), cB + hstep, voffB); PG8_STAGE(PG8_SA(0, 0), cA, voffA); PG8_STAGE(PG8_SA(0, 1), cA + hstep, voffA);
        if (wr == 1) PG8_BAR;
        PG8_WAIT_V(2); PG8_BAR;
        PG8_STAGE(PG8_SB(1, 0), cB + kstep, voffB); PG8_STAGE(PG8_SA(1, 0), cA + kstep, voffA); PG8_STAGE(PG8_SB(1, 1), cB + hstep + kstep, voffB);
        PG8_WAIT_V(6); PG8_BAR;
    } else {
        PG8_STAGE(PG8_SB(0, 0), cB, voffB); PG8_STAGE(PG8_SA(0, 0), cA, voffA); PG8_STAGE(PG8_SB(0, 1), cB + hstep, voffB); PG8_STAGE(PG8_SA(0, 1), cA + hstep, voffA);
        if (wr == 1) PG8_BAR;
        PG8_WAIT_V(4); PG8_BAR;
        PG8_STAGE(PG8_SB(1, 0), cB + kstep, voffB); PG8_STAGE(PG8_SA(1, 0), cA + kstep, voffA); PG8_STAGE(PG8_SB(1, 1), cB + hstep + kstep, voffB);
        PG8_WAIT_V(6); PG8_BAR;
    }
    for (;;) {
        const bool has_next = S.next(ui + 1, nxt);
        const char* nA = has_next ? (const char*)g.A + (size_t)nxt.pm * tstep : cA; const char* nB = has_next ? (const char*)g.Bt + (size_t)nxt.pn * tstep : cB;
        for (int t = 0; t < nt; t += 2) {
            const bool last = (t == nt - 2);
            const char* a1 = cA + (size_t)(t + 1) * kstep;
            const char* a2 = last ? nA : cA + (size_t)(t + 2) * kstep; const char* b2 = last ? nB : cB + (size_t)(t + 2) * kstep;
            const char* a3 = a2 + kstep; const char* b3 = b2 + kstep;
            if (last && has_next) S.a_ready(nxt);
            if constexpr (SP2) {
            PG8_LDB(B0, 0, 0); PG8_LDB(B1, 0, 1); PG8_SCHED; PG8_LDA(At, 0, 0); PG8_STAGE(PG8_SA(1, 1), a1 + hstep, voffA);
            PG8_WAIT_V(8); PG8_WAIT_L(0); PG8_BAR; PG8_MMA(0, 0, At, B0); PG8_MMA(0, 1, At, B1); PG8_BAR; PG8_SCHED;
            PG8_LDA(At, 0, 1); PG8_STAGE(PG8_SB(0, 0), b2, voffB); PG8_STAGE(PG8_SB(0, 1), b2 + hstep, voffB); PG8_STAGE(PG8_SA(0, 0), a2, voffA);
            PG8_WAIT_V(8); PG8_WAIT_L(0); PG8_BAR; PG8_MMA(1, 0, At, B0); PG8_MMA(1, 1, At, B1); PG8_BAR; PG8_SCHED;
            PG8_LDB(B0, 1, 0); PG8_LDB(B1, 1, 1); PG8_SCHED; PG8_LDA(At, 1, 0); PG8_STAGE(PG8_SA(0, 1), a2 + hstep, voffA);
            PG8_WAIT_V(8); PG8_WAIT_L(0); PG8_BAR; PG8_MMA(0, 0, At, B0); PG8_MMA(0, 1, At, B1); PG8_BAR; PG8_SCHED;
            PG8_LDA(At, 1, 1); PG8_STAGE(PG8_SB(1, 0), b3, voffB); PG8_STAGE(PG8_SB(1, 1), b3 + hstep, voffB); PG8_STAGE(PG8_SA(1, 0), a3, voffA);
            PG8_WAIT_V(8); PG8_WAIT_L(0); PG8_BAR; PG8_MMA(1, 0, At, B0); PG8_MMA(1, 1, At, B1); PG8_BAR; PG8_SCHED;
            } else {
            PG8_LDB(B0, 0, 0); PG8_SCHED; PG8_LDA(At, 0, 0); PG8_STAGE(PG8_SA(1, 1), a1 + hstep, voffA);
            PG8_WAIT_L(8); PG8_BAR; PG8_WAIT_L(0); PG8_MMA(0, 0, At, B0); PG8_BAR; PG8_SCHED;
            PG8_LDB(B1, 0, 1); PG8_STAGE(PG8_SB(0, 0), b2, voffB);
            PG8_BAR; PG8_WAIT_L(0); PG8_MMA(0, 1, At, B1); PG8_BAR;
            PG8_LDA(At, 0, 1); PG8_STAGE(PG8_SA(0, 0), a2, voffA);
            PG8_BAR; PG8_WAIT_L(0); PG8_MMA(1, 0, At, B0); PG8_BAR; PG8_SCHED;
            PG8_STAGE(PG8_SB(0, 1), b2 + hstep, voffB);
            PG8_WAIT_V(6); PG8_BAR; PG8_MMA(1, 1, At, B1); PG8_BAR;
            PG8_LDB(B0, 1, 0); PG8_SCHED; PG8_LDA(At, 1, 0); PG8_STAGE(PG8_SA(0, 1), a2 + hstep, voffA);
            PG8_WAIT_L(8); PG8_BAR; PG8_WAIT_L(0); PG8_MMA(0, 0, At, B0); PG8_BAR; PG8_SCHED;
            PG8_LDB(B1, 1, 1); PG8_STAGE(PG8_SB(1, 0), b3, voffB);
            PG8_BAR; PG8_WAIT_L(0); PG8_MMA(0, 1, At, B1); PG8_BAR;
            PG8_LDA(At, 1, 1); PG8_STAGE(PG8_SA(1, 0), a3, voffA);
            PG8_BAR; PG8_WAIT_L(0); PG8_MMA(1, 0, At, B0); PG8_BAR; PG8_SCHED;
            PG8_STAGE(PG8_SB(1, 1), b3 + hstep, voffB);
            PG8_WAIT_V(6); PG8_BAR; PG8_MMA(1, 1, At, B1); PG8_BAR;
            }
        }
        if constexpr (ALIGN_EPI) { if (wr == 0) PG8_BAR; }
        if constexpr (!Epi::AFTER_DRAIN) { int l2_; asm volatile("v_mbcnt_lo_u32_b32 %0, -1, 0\n\tv_mbcnt_hi_u32_b32 %0, -1, %0" : "=v"(l2_)); E(acc, cur, wr, wc, l2_ & 15, l2_ >> 4); S.done(cur); }
        if (!has_next) break;
#pragma unroll
        for (int a = 0; a < 2; ++a)
#pragma unroll
            for (int b = 0; b < 2; ++b)
#pragma unroll
                for (int m = 0; m < 4; ++m)
#pragma unroll
                    for (int n = 0; n < 2; ++n) acc[a][b][m][n] = (f32x4){0.f, 0.f, 0.f, 0.f};
        cur = nxt; cA = nA; cB = nB; ++ui;
        if constexpr (ALIGN_EPI) { if (wr == 1) PG8_BAR; }
    }
    PG8_WAIT_V(0);
    if constexpr (!ALIGN_EPI) { if (wr == 0) PG8_BAR; }
    PG8_BAR;
    if constexpr (Epi::AFTER_DRAIN) { E.fused(acc, cur, wr, wc, fr, fq, lds, wid, lane); S.done(cur); }
#undef PG8_SA
#undef PG8_SB
#undef PG8_STAGE
#undef PG8_LDA
#undef PG8_LDB
#undef PG8_MMA
#undef PG8_WAIT_V
#undef PG8_WAIT_L
#undef PG8_BAR
#undef PG8_SCHED
}
}

constexpr int NWAVES = 8;
constexpr int BATCH = 4, SEQ = 2048, DM = 2048, MTOK = BATCH * SEQ, MEMLEN = 256, MMEM = BATCH * MEMLEN, INC = 6144, DFF = 5632;
constexpr float NORM_EPS = 1e-6f;
constexpr size_t MiB = 1u << 20;
constexpr size_t WS_CTL = 0, CTL_ZERO_BYTES = 64 * 1024;
constexpr size_t WS_SSQ = 1 * MiB;
constexpr size_t WS_WIN = 2 * MiB, WS_WO = 26 * MiB, WS_WXQ = 34 * MiB, WS_WXKV = 42 * MiB, WS_WXO = 58 * MiB, WS_WGU = 66 * MiB, WS_WD = 110 * MiB;
constexpr size_t WS_HM = 132 * MiB, WS_XKV = 136 * MiB;
constexpr size_t WS_B = 144 * MiB;
constexpr size_t WS_C = 176 * MiB;
constexpr size_t WS_A = 208 * MiB;
constexpr size_t WS_END = 304 * MiB;
constexpr int CW_BAR = 4096, CW_Q = 8192;
constexpr int RING_OFF = 0, RING_BYTES = 131072;
constexpr int NAIVE_WAVE_BYTES = 17408;
constexpr int LDSCTL_OFF = 143360, MISC_OFF = LDSCTL_OFF + 320;
constexpr int LDS_BYTES = 147456;
static_assert(NWAVES * NAIVE_WAVE_BYTES <= LDSCTL_OFF && MISC_OFF + 128 <= LDS_BYTES, "LDS map");

#define GAS __attribute__((address_space(1)))
#define LAS __attribute__((address_space(3)))
typedef unsigned short bf16;
typedef unsigned v4u __attribute__((ext_vector_type(4)));
typedef unsigned v2u __attribute__((ext_vector_type(2)));
typedef float f32x4 __attribute__((ext_vector_type(4)));
typedef GAS unsigned gu32;
#define RLX_AGENT __ATOMIC_RELAXED, __HIP_MEMORY_SCOPE_AGENT
#define LDS_WAIT() asm volatile("s_waitcnt lgkmcnt(0)" ::: "memory")
#define VM_WAIT() asm volatile("s_waitcnt vmcnt(0)" ::: "memory")
__device__ __forceinline__ unsigned f2bf(float f) { unsigned u = __builtin_bit_cast(unsigned, f); return (u + 0x7fffu + ((u >> 16) & 1u)) >> 16; }
__device__ __forceinline__ unsigned pk2(float lo, float hi) { return f2bf(lo) | (f2bf(hi) << 16); }
__device__ __forceinline__ float bflo(unsigned w) { return __uint_as_float(w << 16); }
__device__ __forceinline__ float bfhi(unsigned w) { return __uint_as_float(w & 0xffff0000u); }
__device__ __forceinline__ float bf2f(bf16 v) { return __uint_as_float(((unsigned)v) << 16); }

#define XB_TMO      128
#define XB_XCNT(j)  (256  + 64 * (j))
#define XB_XSUB(j)  (1280 + 64 * (j))
#define XB_XGEN(j)  (2304 + 64 * (j))
#define XB_TOP      3328
#define XB_TOPGEN   3392
#define XCD_BAR_WORDS 3456
#define XB_SPIN_CAP (1u << 22)
__device__ __forceinline__ unsigned xb_ld(unsigned* p)              { return __hip_atomic_load(p, __ATOMIC_RELAXED, __HIP_MEMORY_SCOPE_AGENT); }
__device__ __forceinline__ unsigned xb_add(unsigned* p, unsigned v) { return __hip_atomic_fetch_add(p, v, __ATOMIC_RELAXED, __HIP_MEMORY_SCOPE_AGENT); }
__device__ __forceinline__ unsigned xb_xcc_id() { return (unsigned)__builtin_amdgcn_s_getreg((3 << 11) | 20) & 0xFu; }
#define XB_SPIN(cond, bar) do { unsigned _sp = 0; while (cond) { __builtin_amdgcn_s_sleep(1); \
    if ((++_sp & 255u) == 0u) { if (xb_ld(&(bar)[XB_TMO])) break; if (_sp > XB_SPIN_CAP) { atomicAdd(&(bar)[XB_TMO], 1u); break; } } } } while (0)
struct XcdBarrier { unsigned* bar; unsigned x; volatile LAS unsigned* st; };
__device__ __forceinline__ XcdBarrier xcd_barrier_post(unsigned* bar, volatile LAS unsigned* st) {
    XcdBarrier b; b.bar = bar; b.x = xb_xcc_id(); b.st = st;
    if (threadIdx.x == 0) (void)xb_add(&bar[XB_XCNT(b.x)], 1u);
    return b;
}
__device__ __forceinline__ void xcd_barrier_complete(unsigned* bar, unsigned x, unsigned& nloc, unsigned& nx) {
    const unsigned G = gridDim.x * gridDim.y * gridDim.z;
    unsigned sum, cnt, mine, sp = 0u;
    for (;;) {
        sum = 0u; cnt = 0u; mine = 0u;
#pragma unroll
        for (unsigned j = 0; j < 16; ++j) { const unsigned c = xb_ld(&bar[XB_XCNT(j)]); sum += c; cnt += (c > 0u) ? 1u : 0u; mine = (j == x) ? c : mine; }
        if (sum == G) break;
        __builtin_amdgcn_s_sleep(1);
        if ((++sp & 255u) == 0u) { if (xb_ld(&bar[XB_TMO])) break; if (sp > XB_SPIN_CAP) { atomicAdd(&bar[XB_TMO], 1u); break; } }
    }
    nloc = mine > 0u ? mine : 1u; nx = cnt > 0u ? cnt : 1u;
}
__device__ __forceinline__ void xcd_barrier(const XcdBarrier& b) {
    asm volatile("s_waitcnt vmcnt(0)" ::: "memory");
    __syncthreads();
    if (threadIdx.x == 0) {
        unsigned* bar = b.bar;
        __builtin_amdgcn_s_waitcnt(0);
        unsigned nloc = b.st[0], nx = b.st[1];
        if (nloc == 0u) { xcd_barrier_complete(bar, b.x, nloc, nx); b.st[0] = nloc; b.st[1] = nx; }
        const unsigned old = xb_add(&bar[XB_XSUB(b.x)], 1u);
        const unsigned gen = old / nloc;
        if (old + 1u == (gen + 1u) * nloc) {
            __builtin_amdgcn_fence(__ATOMIC_RELEASE, "agent");
            asm volatile("s_waitcnt vmcnt(0)" ::: "memory");
            const unsigned og = xb_add(&bar[XB_TOP], 1u);
            const unsigned tg = og / nx;
            if (og + 1u == (tg + 1u) * nx) xb_add(&bar[XB_TOPGEN], 1u);
            else XB_SPIN(xb_ld(&bar[XB_TOPGEN]) == tg, bar);
            __builtin_amdgcn_fence(__ATOMIC_ACQUIRE, "agent");
            xb_add(&bar[XB_XGEN(b.x)], 1u);
            asm volatile("s_waitcnt vmcnt(0)" ::: "memory");
        } else {
            XB_SPIN(xb_ld(&bar[XB_XGEN(b.x)]) == gen, bar);
            __builtin_amdgcn_fence(__ATOMIC_ACQUIRE, "agent");
            asm volatile("s_waitcnt vmcnt(0)" ::: "memory");
        }
    }
    __syncthreads();
}

__device__ __forceinline__ int lane_id_fresh() { int l; asm volatile("v_mbcnt_lo_u32_b32 %0, -1, 0\n\tv_mbcnt_hi_u32_b32 %0, -1, %0" : "=v"(l)); return l; }
template <int X> __device__ __forceinline__ float swz_xor(float v) { return __int_as_float(__builtin_amdgcn_ds_swizzle(__float_as_int(v), (X << 10) | 0x1f)); }
__device__ __forceinline__ float wave_sum(float v) {
    v += swz_xor<1>(v); v += swz_xor<2>(v); v += swz_xor<4>(v); v += swz_xor<8>(v); v += swz_xor<16>(v);
    auto rr = __builtin_amdgcn_permlane32_swap(__float_as_uint(v), __float_as_uint(v), false, false); return __uint_as_float(rr[0]) + __uint_as_float(rr[1]);
}
__device__ __forceinline__ float wave_max(float v) {
    v = fmaxf(v, swz_xor<1>(v)); v = fmaxf(v, swz_xor<2>(v)); v = fmaxf(v, swz_xor<4>(v)); v = fmaxf(v, swz_xor<8>(v)); v = fmaxf(v, swz_xor<16>(v));
    auto rr = __builtin_amdgcn_permlane32_swap(__float_as_uint(v), __float_as_uint(v), false, false); return fmaxf(__uint_as_float(rr[0]), __uint_as_float(rr[1]));
}

__device__ __forceinline__ void p0_transpose_item(const float* W, int K, int N, bf16* WT, int mode, int row_off, const float* gain, LAS float* scr, int item, int lane) {
    const int nblk = N / 32, kb = item / nblk, nb = item % nblk, k0 = 64 * kb, n0 = 32 * nb;
    float wv[32];
    const float* Wp = W + (size_t)(k0 + (lane >> 5)) * N + n0 + (lane & 31);
#pragma unroll
    for (int i = 0; i < 32; ++i) wv[i] = Wp[(size_t)(2 * i) * N];
    if (gain) {
#pragma unroll
        for (int i = 0; i < 32; ++i) wv[i] *= gain[k0 + 2 * i + (lane >> 5)];
    }
#pragma unroll
    for (int i = 0; i < 32; ++i) scr[(2 * i + (lane >> 5)) * 33 + (lane & 31)] = wv[i];
    LDS_WAIT(); asm volatile("" ::: "memory");
    const int c = lane & 7;
    const int r0 = (mode == 0) ? (row_off + n0) : (256 * (n0 >> 7) + 128 * (mode - 1) + (n0 & 127));
#pragma unroll
    for (int j = 0; j < 4; ++j) { const int n = (lane >> 3) + 8 * j; const LAS float* s = scr + (8 * c) * 33 + n;
        v4u o; o.x = pk2(s[0 * 33], s[1 * 33]); o.y = pk2(s[2 * 33], s[3 * 33]); o.z = pk2(s[4 * 33], s[5 * 33]); o.w = pk2(s[6 * 33], s[7 * 33]);
        *(v4u*)(WT + (size_t)(r0 + n) * K + k0 + 8 * c) = o; }
    LDS_WAIT(); asm volatile("" ::: "memory");
}
__device__ __forceinline__ void rms_row_to_bf16(const float* xrow, const float* g, bf16* orow, int lane) {
    const f32x4* xr = (const f32x4*)xrow + lane; const f32x4* gr = (const f32x4*)g + lane;
    f32x4 v[8]; float s = 0.f;
#pragma unroll
    for (int j = 0; j < 8; ++j) { v[j] = xr[64 * j]; s += (v[j].x * v[j].x + v[j].y * v[j].y) + (v[j].z * v[j].z + v[j].w * v[j].w); }
    const float r = 1.0f / sqrtf(wave_sum(s) * (1.f / DM) + NORM_EPS);
    v2u* o8 = (v2u*)orow + lane;
#pragma unroll
    for (int j = 0; j < 8; ++j) { const f32x4 gg = gr[64 * j]; v2u w; w.x = pk2(v[j].x * r * gg.x, v[j].y * r * gg.y); w.y = pk2(v[j].z * r * gg.z, v[j].w * r * gg.w); o8[64 * j] = w; }
}

__device__ __forceinline__ float dot_lds_bf16(const LAS float* q, const bf16* k, int n) {
    float s = 0.f;
    for (int d = 0; d < n; d += 8) { const v4u w = *(const v4u*)(k + d);
        s += q[d] * bflo(w.x) + q[d + 1] * bfhi(w.x) + q[d + 2] * bflo(w.y) + q[d + 3] * bfhi(w.y) + q[d + 4] * bflo(w.z) + q[d + 5] * bfhi(w.z) + q[d + 6] * bflo(w.w) + q[d + 7] * bfhi(w.w); }
    return s;
}
__device__ __forceinline__ void naive_da_item(const bf16* P, bf16* MIX, const float* subg, float lam, int b, int h, int i, LAS float* scr, int lane) {
    const size_t rowq = (size_t)(b * SEQ + i) * INC;
    LAS float* qs = scr; LAS float* tmp = scr + 256; LAS float* as = scr + 256 + 2048;
    for (int t = lane; t < 256; t += 64) qs[t] = bf2f(P[rowq + h * 256 + t]);
    LDS_WAIT(); asm volatile("" ::: "memory");
    const float slope = exp2f(-2.0f * (float)(h + 1)), scale = 0.08838834764831845f;
    for (int c = 0; c < 2; ++c) {
        float mx = -3.0e38f;
        for (int j = lane; j <= i; j += 64) {
            const bf16* kr = P + (size_t)(b * SEQ + j) * INC + 1024 + h * 256 + c * 128;
            float s = dot_lds_bf16(qs + c * 128, kr, 128);
            s = s * scale - slope * (float)(i - j);
            tmp[j] = s; mx = fmaxf(mx, s);
        }
        mx = wave_max(mx);
        float sum = 0.f;
        for (int j = lane; j <= i; j += 64) { const float p = __expf(tmp[j] - mx); tmp[j] = p; sum += p; }
        sum = wave_sum(sum);
        const float inv = 1.0f / sum;
        for (int j = lane; j <= i; j += 64) { if (c == 0) as[j] = tmp[j] * inv; else as[j] -= lam * tmp[j] * inv; }
    }
    LDS_WAIT(); asm volatile("" ::: "memory");
    float o0 = 0.f, o1 = 0.f, o2 = 0.f, o3 = 0.f;
    const bf16* vb = P + (size_t)(b * SEQ) * INC + 2048 + h * 256 + 4 * lane;
    for (int j = 0; j <= i; ++j) { const float a = as[j]; const v2u w = *(const v2u*)(vb + (size_t)j * INC);
        o0 += a * bflo(w.x); o1 += a * bfhi(w.x); o2 += a * bflo(w.y); o3 += a * bfhi(w.y); }
    const float ss = wave_sum(o0 * o0 + o1 * o1 + o2 * o2 + o3 * o3);
    const float r = 0.8f / sqrtf(ss * (1.0f / 256.0f) + NORM_EPS);
    const f32x4 g = *(const f32x4*)(subg + 4 * lane);
    v2u w; w.x = pk2(o0 * r * g.x, o1 * r * g.y); w.y = pk2(o2 * r * g.z, o3 * r * g.w);
    *(v2u*)(MIX + (size_t)(b * SEQ + i) * DM + h * 256 + 4 * lane) = w;
    LDS_WAIT(); asm volatile("" ::: "memory");
}
__device__ __forceinline__ void naive_ret_item(const bf16* P, bf16* MIX, int b, int h, int i, LAS float* scr, int lane) {
    const size_t rowq = (size_t)(b * SEQ + i) * INC;
    LAS float* qs = scr; LAS float* as = scr + 256;
    for (int t = lane; t < 128; t += 64) qs[t] = bf2f(P[rowq + 3072 + h * 128 + t]);
    LDS_WAIT(); asm volatile("" ::: "memory");
    const float lg = logf(1.0f - exp2f(-5.0f - (float)h)), scale = 0.08838834764831845f;
    for (int j = lane; j <= i; j += 64) {
        const bf16* kr = P + (size_t)(b * SEQ + j) * INC + 3584 + h * 128;
        const float s = dot_lds_bf16(qs, kr, 128);
        as[j] = s * scale * __expf(lg * (float)(i - j));
    }
    LDS_WAIT(); asm volatile("" ::: "memory");
    float o0 = 0.f, o1 = 0.f, o2 = 0.f, o3 = 0.f;
    const bf16* vb = P + (size_t)(b * SEQ) * INC + 4096 + h * 256 + 4 * lane;
    for (int j = 0; j <= i; ++j) { const float a = as[j]; const v2u w = *(const v2u*)(vb + (size_t)j * INC);
        o0 += a * bflo(w.x); o1 += a * bfhi(w.x); o2 += a * bflo(w.y); o3 += a * bfhi(w.y); }
    const float ss = wave_sum(o0 * o0 + o1 * o1 + o2 * o2 + o3 * o3);
    const float r = 1.0f / sqrtf(ss * (1.0f / 256.0f) + NORM_EPS);
    const v2u gw = *(const v2u*)(P + rowq + 5120 + h * 256 + 4 * lane);
    const float g0 = bflo(gw.x), g1 = bfhi(gw.x), g2 = bflo(gw.y), g3 = bfhi(gw.y);
    v2u w; w.x = pk2(o0 * r * (g0 / (1.0f + __expf(-g0))), o1 * r * (g1 / (1.0f + __expf(-g1)))); w.y = pk2(o2 * r * (g2 / (1.0f + __expf(-g2))), o3 * r * (g3 / (1.0f + __expf(-g3))));
    *(v2u*)(MIX + (size_t)(b * SEQ + i) * DM + 1024 + h * 256 + 4 * lane) = w;
    LDS_WAIT(); asm volatile("" ::: "memory");
}
__device__ __forceinline__ void naive_xattn_item(const bf16* XQ, const bf16* XKV, bf16* XO, int b, int h, int i, LAS float* scr, int lane) {
    const size_t rowq = (size_t)(b * SEQ + i) * DM + h * 512;
    LAS float* qs = scr; LAS float* as = scr + 512;
    for (int t = lane; t < 512; t += 64) qs[t] = bf2f(XQ[rowq + t]);
    LDS_WAIT(); asm volatile("" ::: "memory");
    const float scale = 0.044194173824159216f;
    float sc[4]; float mx = -3.0e38f;
#pragma unroll
    for (int t = 0; t < 4; ++t) { const int j = lane + 64 * t; sc[t] = dot_lds_bf16(qs, XKV + (size_t)(b * MEMLEN + j) * 4096 + h * 512, 512) * scale; mx = fmaxf(mx, sc[t]); }
    mx = wave_max(mx);
    float sum = 0.f;
#pragma unroll
    for (int t = 0; t < 4; ++t) { sc[t] = __expf(sc[t] - mx); sum += sc[t]; }
    sum = wave_sum(sum);
    const float inv = 1.0f / sum;
#pragma unroll
    for (int t = 0; t < 4; ++t) as[lane + 64 * t] = sc[t] * inv;
    LDS_WAIT(); asm volatile("" ::: "memory");
    float o[8];
#pragma unroll
    for (int e = 0; e < 8; ++e) o[e] = 0.f;
    const bf16* vb = XKV + (size_t)(b * MEMLEN) * 4096 + 2048 + h * 512 + 8 * lane;
    for (int j = 0; j < MEMLEN; ++j) { const float a = as[j]; const v4u w = *(const v4u*)(vb + (size_t)j * 4096);
        o[0] += a * bflo(w.x); o[1] += a * bfhi(w.x); o[2] += a * bflo(w.y); o[3] += a * bfhi(w.y); o[4] += a * bflo(w.z); o[5] += a * bfhi(w.z); o[6] += a * bflo(w.w); o[7] += a * bfhi(w.w); }
    v4u w; w.x = pk2(o[0], o[1]); w.y = pk2(o[2], o[3]); w.z = pk2(o[4], o[5]); w.w = pk2(o[6], o[7]);
    *(v4u*)(XO + rowq + 8 * lane) = w;
    LDS_WAIT(); asm volatile("" ::: "memory");
}


namespace att {
typedef short bf16x8 __attribute__((ext_vector_type(8)));
typedef short s16x4 __attribute__((ext_vector_type(4)));
typedef float f32x16 __attribute__((ext_vector_type(16)));
typedef unsigned u32x4 __attribute__((ext_vector_type(4)));
#define ATT_SBAR() __builtin_amdgcn_sched_barrier(0)
__device__ __forceinline__ int crow(int r, int hi) { return (r & 3) + 8 * (r >> 2) + 4 * hi; }
__device__ __forceinline__ unsigned cvtpk(float lo, float hi) { unsigned r; asm volatile("v_cvt_pk_bf16_f32 %0, %1, %2" : "=v"(r) : "v"(lo), "v"(hi)); return r; }
#define ATT_KSWZ(row, colB) ((row) * 256 + ((colB) ^ (((row) & 7) << 4)))
__device__ __forceinline__ int v_rd_base(int lane) { return ((lane & 3) << 3) | (((lane >> 2) & 3) << 6) | (((lane >> 4) & 1) << 5) | (((lane >> 5) & 1) << 8); }
__device__ __forceinline__ s16x4 vtr(const LAS unsigned char* p) { return __builtin_bit_cast(s16x4, __builtin_amdgcn_ds_read_tr16_b64_v4i16((LAS s16x4*)p)); }
#define ATT_PK4(P, BASE, OUT) do { unsigned a0_ = att::cvtpk(P[BASE + 0], P[BASE + 1]), a1_ = att::cvtpk(P[BASE + 2], P[BASE + 3]);   \
    unsigned b0_ = att::cvtpk(P[BASE + 4], P[BASE + 5]), b1_ = att::cvtpk(P[BASE + 6], P[BASE + 7]);                              \
    auto r0_ = __builtin_amdgcn_permlane32_swap(a0_, b0_, false, false); auto r1_ = __builtin_amdgcn_permlane32_swap(a1_, b1_, false, false); \
    att::u32x4 w_ = {r0_[0], r1_[0], r0_[1], r1_[1]}; OUT = __builtin_bit_cast(att::bf16x8, w_); } while (0)
template <int OFF> __device__ __forceinline__ s16x4 trr(unsigned a) { s16x4 r; asm volatile("ds_read_b64_tr_b16 %0, %1 offset:%2" : "=v"(r) : "v"(a), "i"(OFF)); return r; }
__device__ __forceinline__ bf16x8 lds128(unsigned a) { bf16x8 r; asm volatile("ds_read_b128 %0, %1" : "=v"(r) : "v"(a)); return r; }
#define ATT_LGKM(n) asm volatile("s_waitcnt lgkmcnt(" #n ")" ::: "memory")
#define ATT_VLOAD4(S, O0, O1, O2, O3, HS) do { S[0] = att::trr<(O0)>(va_); S[1] = att::trr<(O0) + (HS)>(va_); S[2] = att::trr<(O1)>(va_); S[3] = att::trr<(O1) + (HS)>(va_); \
    S[4] = att::trr<(O2)>(va_); S[5] = att::trr<(O2) + (HS)>(va_); S[6] = att::trr<(O3)>(va_); S[7] = att::trr<(O3) + (HS)>(va_); } while (0)
#define ATT_VFRAG(S, i) (att::bf16x8){S[2 * (i)][0], S[2 * (i)][1], S[2 * (i)][2], S[2 * (i)][3], S[2 * (i) + 1][0], S[2 * (i) + 1][1], S[2 * (i) + 1][2], S[2 * (i) + 1][3]}
#define ATT_MMA4(S, OA, PA, OB, PB, OC, PC, OD, PD) do { OA = __builtin_amdgcn_mfma_f32_32x32x16_bf16(PA, ATT_VFRAG(S, 0), OA, 0, 0, 0); OB = __builtin_amdgcn_mfma_f32_32x32x16_bf16(PB, ATT_VFRAG(S, 1), OB, 0, 0, 0); \
    OC = __builtin_amdgcn_mfma_f32_32x32x16_bf16(PC, ATT_VFRAG(S, 2), OC, 0, 0, 0); OD = __builtin_amdgcn_mfma_f32_32x32x16_bf16(PD, ATT_VFRAG(S, 3), OD, 0, 0, 0); } while (0)
template <int HF> __device__ __forceinline__ void pv_half(f32x16 (&o)[8], const bf16x8 pa0, const bf16x8 pa1, const unsigned va_) {
    s16x4 A[8], B[8];
#define ATT_G(S, G) ATT_VLOAD4(S, (2 * (G)) * 512 + (2 * HF) * 8192, (2 * (G)) * 512 + (2 * HF + 1) * 8192, (2 * (G) + 1) * 512 + (2 * HF) * 8192, (2 * (G) + 1) * 512 + (2 * HF + 1) * 8192, 4096)
#define ATT_M(S, G) ATT_MMA4(S, o[2 * (G)], pa0, o[2 * (G)], pa1, o[2 * (G) + 1], pa0, o[2 * (G) + 1], pa1)
    ATT_G(A, 0);
    ATT_G(B, 1); ATT_LGKM(8); ATT_SBAR(); ATT_M(A, 0); ATT_SBAR();
    ATT_G(A, 2); ATT_LGKM(8); ATT_SBAR(); ATT_M(B, 1); ATT_SBAR();
    ATT_G(B, 3); ATT_LGKM(8); ATT_SBAR(); ATT_M(A, 2); ATT_SBAR();
    ATT_LGKM(0); ATT_SBAR(); ATT_M(B, 3);
#undef ATT_G
#undef ATT_M
}
template <int D0> __device__ __forceinline__ void pv_x(f32x16& o, const bf16x8 (&pa)[16], const unsigned va_) {
    s16x4 A[8], B[8];
#define ATT_G(S, Q) ATT_VLOAD4(S, D0 * 512 + (4 * (Q)) * 4096, D0 * 512 + (4 * (Q) + 1) * 4096, D0 * 512 + (4 * (Q) + 2) * 4096, D0 * 512 + (4 * (Q) + 3) * 4096, 2048)
#define ATT_M(S, Q) ATT_MMA4(S, o, pa[4 * (Q)], o, pa[4 * (Q) + 1], o, pa[4 * (Q) + 2], o, pa[4 * (Q) + 3])
    ATT_G(A, 0);
    ATT_G(B, 1); ATT_LGKM(8); ATT_SBAR(); ATT_M(A, 0); ATT_SBAR();
    ATT_G(A, 2); ATT_LGKM(8); ATT_SBAR(); ATT_M(B, 1); ATT_SBAR();
    ATT_G(B, 3); ATT_LGKM(8); ATT_SBAR(); ATT_M(A, 2); ATT_SBAR();
    ATT_LGKM(0); ATT_SBAR(); ATT_M(B, 3);
#undef ATT_G
#undef ATT_M
}
__device__ __forceinline__ void glds16(const void* gsrc, LAS unsigned char* lds_dst) { __builtin_amdgcn_global_load_lds((const unsigned*)gsrc, (LAS unsigned*)lds_dst, 16, 0, 0); }
__device__ __forceinline__ void k_src(int n, int L, int& row, int& chunk) { row = 4 * n + (L >> 4); chunk = (L & 15) ^ (row & 7); }
template <int NCB> __device__ __forceinline__ void v_src(int n, int L, int& key, int& col) {
    const int off = n * 1024 + 16 * L, s = off >> 9, within = off & 511, kk7 = within >> 6, col8 = (within & 63) >> 1;
    const int kk = ((s / NCB) << 3) | kk7; key = (kk & ~0xC) | ((kk & 4) << 1) | ((kk & 8) >> 1); col = (s % NCB) * 32 + col8;
}
__device__ __forceinline__ float halfmax(float m) { auto rr = __builtin_amdgcn_permlane32_swap(__float_as_uint(m), __float_as_uint(m), false, false); return fmaxf(__uint_as_float(rr[0]), __uint_as_float(rr[1])); }
__device__ __forceinline__ float halfsum(float m) { auto rr = __builtin_amdgcn_permlane32_swap(__float_as_uint(m), __float_as_uint(m), false, false); return __uint_as_float(rr[0]) + __uint_as_float(rr[1]); }

__device__ __forceinline__ void stage_voffs(int lane, unsigned pitch, unsigned& vk0, unsigned& vk1, unsigned& vv) {
    vk0 = (unsigned)(lane >> 4) * pitch + (unsigned)(((lane & 15) ^ ((lane >> 4) & 7)) * 16);
    vk1 = (unsigned)(lane >> 4) * pitch + (unsigned)(((lane & 15) ^ ((4 + (lane >> 4)) & 7)) * 16);
    vv = (unsigned)(((lane >> 4) & 1) * 8 + ((lane >> 2) & 3)) * pitch + (unsigned)(((lane >> 5) * 32 + 8 * (lane & 3)) * 2);
}
__device__ __forceinline__ void xattn_stage(LAS unsigned char* buf, const bf16* XKV, int b, int h, int c, int wid, unsigned vk0, unsigned vk1, unsigned vv) {
    const char* base = (const char*)(XKV + (size_t)(b * MEMLEN) * 4096 + h * 512);
    if (c < 4) {
#pragma unroll
        for (int t = 0; t < 8; ++t) glds16(base + (size_t)((32 * wid + 4 * t) * 8192 + c * 256) + ((t & 1) ? vk1 : vk0), buf + (wid * 8 + t) * 1024);
    } else {
#pragma unroll
        for (int t = 0; t < 8; ++t) glds16(base + (size_t)((32 * wid + 16 * (t >> 2) + 4 * ((t >> 1) & 1)) * 8192 + (2048 + (c - 4) * 128 + 64 * (t & 1)) * 2) + vv, buf + (wid * 8 + t) * 1024);
    }
}
__device__ __forceinline__ void xattn_unit(LAS unsigned char* L, const bf16* XQ, const bf16* XKV, bf16* XO, int b, int h, int qb, const int wid) {
    const int lane = lane_id_fresh();
    const int r32 = lane & 31, hi = lane >> 5;
    const size_t row0 = (size_t)(b * SEQ + qb * 256 + wid * 32);
    const bf16* Qw = XQ + (row0 + r32) * DM + h * 512 + hi * 8;
    f32x16 p[8];
#pragma unroll
    for (int kb = 0; kb < 8; ++kb) p[kb] = f32x16{};
    bf16x8 qc[8];
#pragma unroll
    for (int d0 = 0; d0 < 8; ++d0) qc[d0] = *(const bf16x8*)(Qw + d0 * 16);
    unsigned vk0, vk1, vv; stage_voffs(lane, 8192u, vk0, vk1, vv);
    xattn_stage(L, XKV, b, h, 0, wid, vk0, vk1, vv);
    asm volatile("s_waitcnt vmcnt(0)" ::: "memory"); __syncthreads();
#pragma unroll 1
    for (int c = 0; c < 4; ++c) {
        LAS unsigned char* cur = L + (c & 1) * 65536; LAS unsigned char* nxt = L + ((c + 1) & 1) * 65536;
        xattn_stage(nxt, XKV, b, h, c + 1, wid, vk0, vk1, vv);
#pragma unroll
        for (int kb = 0; kb < 8; ++kb)
#pragma unroll
            for (int d0 = 0; d0 < 8; ++d0) { const int cb = (d0 * 16 + hi * 8) * 2;
                const bf16x8 kf = *(const LAS bf16x8*)(cur + ATT_KSWZ(kb * 32 + r32, cb));
                p[kb] = __builtin_amdgcn_mfma_f32_32x32x16_bf16(kf, qc[d0], p[kb], 0, 0, 0); }
        if (c < 3) {
#pragma unroll
            for (int d0 = 0; d0 < 8; ++d0) qc[d0] = *(const bf16x8*)(Qw + (c + 1) * 128 + d0 * 16);
        }
        asm volatile("s_waitcnt vmcnt(0)" ::: "memory"); __syncthreads();
    }
    constexpr float C = 0.044194173824159216f * 1.4426950408889634f;
    float mx = -3.0e38f;
#pragma unroll
    for (int kb = 0; kb < 8; ++kb)
#pragma unroll
        for (int r = 0; r < 16; ++r) mx = fmaxf(mx, p[kb][r]);
    mx = halfmax(mx);
    const float mC = -mx * C; float sum = 0.f;
#pragma unroll
    for (int kb = 0; kb < 8; ++kb)
#pragma unroll
        for (int r = 0; r < 16; ++r) { p[kb][r] = __builtin_amdgcn_exp2f(fmaf(p[kb][r], C, mC)); sum += p[kb][r]; }
    sum = halfsum(sum);
    const float inv = 1.0f / sum;
    bf16x8 pa[16];
#pragma unroll
    for (int kb = 0; kb < 8; ++kb) {
#pragma unroll
        for (int r = 0; r < 16; ++r) p[kb][r] *= inv;
        ATT_PK4(p[kb], 0, pa[2 * kb]); ATT_PK4(p[kb], 8, pa[2 * kb + 1]);
    }
    const int vb = v_rd_base(lane);
#pragma unroll 1
    for (int c = 4; c < 8; ++c) {
        LAS unsigned char* cur = L + (c & 1) * 65536; LAS unsigned char* nxt = L + ((c + 1) & 1) * 65536;
        if (c < 7) xattn_stage(nxt, XKV, b, h, c + 1, wid, vk0, vk1, vv);
        f32x16 o[4];
#pragma unroll
        for (int d0 = 0; d0 < 4; ++d0) o[d0] = f32x16{};
        { const unsigned va_ = (unsigned)(size_t)(cur + vb); pv_x<0>(o[0], pa, va_); pv_x<1>(o[1], pa, va_); pv_x<2>(o[2], pa, va_); pv_x<3>(o[3], pa, va_); }
        { LAS unsigned short* st = (LAS unsigned short*)(L + 131072 + wid * 1024);
          bf16* Ow = XO + row0 * DM + h * 512 + (c - 4) * 128;
#pragma unroll
          for (int d0 = 0; d0 < 4; ++d0)
#pragma unroll
              for (int rh = 0; rh < 2; ++rh) {
#pragma unroll
                  for (int r = 0; r < 8; ++r) st[(crow(8 * rh + r, hi) & 15) * 32 + r32] = (unsigned short)f2bf(o[d0][8 * rh + r]);
                  asm volatile("s_waitcnt lgkmcnt(0)" ::: "memory");
                  const u32x4 w = *(const LAS u32x4*)(st + (lane >> 2) * 32 + (lane & 3) * 8);
                  *(u32x4*)(Ow + (size_t)(16 * rh + (lane >> 2)) * DM + d0 * 32 + (lane & 3) * 8) = w;
                  asm volatile("s_waitcnt lgkmcnt(0)" ::: "memory"); } }
        asm volatile("s_waitcnt vmcnt(0)" ::: "memory"); __syncthreads();
    }
}

template <int MODE> __device__ __forceinline__ void causal_stage(LAS unsigned char* buf, const bf16* PROJ, int b, int h, int j, int wid, unsigned vk0, unsigned vk1, unsigned vv) {
    const size_t rowb = (size_t)(b * SEQ + 64 * j) * 512;
    const char* kbase = (const char*)PROJ + (size_t)(MODE == 0 ? 4 + h : 14 + (h >> 1)) * ((size_t)MTOK * 512) + rowb + (MODE == 0 ? 0 : (h & 1) * 256);
    const char* vbase = (const char*)PROJ + (size_t)(MODE == 0 ? 8 + h : 16 + h) * ((size_t)MTOK * 512) + rowb;
#pragma unroll
    for (int t = 0; t < 2; ++t) { const int n = 2 * wid + t; const size_t ro = (size_t)(8 * wid + 4 * t) * 512; const unsigned vk = t ? vk1 : vk0;
        if (MODE == 0) { glds16(kbase + ro + vk, buf + n * 1024); glds16(kbase + ro + 256 + vk, buf + 16384 + n * 1024); }
        else glds16(kbase + ro + vk, buf + n * 1024); }
#pragma unroll
    for (int t = 0; t < 4; ++t) { const int n = 4 * wid + t;
        glds16(vbase + (size_t)((wid >> 1) * 16 + (wid & 1) * 4) * 512 + (64 * t) * 2 + vv, buf + (MODE == 0 ? 32768 : 16384) + n * 1024); }
}
template <int MODE> __device__ __forceinline__ void causal_unit(LAS unsigned char* L, const bf16* PROJ, bf16* MIX, const float* subg, float lam, int b, int h, int i, const int wid) {
    constexpr int TILE_BYTES = MODE == 0 ? 65536 : 49152, V_OFF = MODE == 0 ? 32768 : 16384;
    constexpr float NEG = -1.0e30f, LOG2E = 1.4426950408889634f, C = 0.08838834764831845f * LOG2E;
    const int lane = lane_id_fresh();
    const int r32 = lane & 31, hi = lane >> 5;
    const int w4 = MODE == 0 ? (wid & 3) : wid, comp = MODE == 0 ? (wid >> 2) : 0;
    const int R0 = (MODE == 0 ? 128 : 256) * i + 32 * w4, NT = (MODE == 0 ? 2 : 4) * (i + 1), qpos = R0 + r32;
    const bf16* Qw = PROJ + (size_t)(MODE == 0 ? h : 12 + (h >> 1)) * ((size_t)MTOK * 256) + (size_t)(b * SEQ + qpos) * 256 + (MODE == 0 ? comp * 128 : (h & 1) * 128) + hi * 8;
    bf16x8 qr[8];
#pragma unroll
    for (int d0 = 0; d0 < 8; ++d0) qr[d0] = *(const bf16x8*)(Qw + d0 * 16);
    const float slope2 = __uint_as_float(__builtin_amdgcn_readfirstlane(__float_as_uint(MODE == 0 ? __builtin_amdgcn_exp2f(-2.0f * (float)(h + 1)) * LOG2E : -__builtin_amdgcn_logf(1.0f - __builtin_amdgcn_exp2f(-5.0f - (float)h)))));
    float m = NEG, l = 0.f; f32x16 o[8];
#pragma unroll
    for (int d0 = 0; d0 < 8; ++d0) o[d0] = f32x16{};
    LAS float* al = (LAS float*)(L + 131072 + 256 * wid); LAS float* li = al + 32;
    const int vb = v_rd_base(lane);
    unsigned vk0, vk1, vv; stage_voffs(lane, 512u, vk0, vk1, vv);
    causal_stage<MODE>(L, PROJ, b, h, 0, wid, vk0, vk1, vv);
    unsigned pf_ = 0u;
    asm volatile("s_waitcnt vmcnt(0)" ::: "memory"); __syncthreads();
#pragma unroll 1
    for (int j = 0; j < NT; ++j) {
        LAS unsigned char* cur = L + (j & 1) * TILE_BYTES; LAS unsigned char* nxt = L + ((j + 1) & 1) * TILE_BYTES;
        if (j + 1 < NT) causal_stage<MODE>(nxt, PROJ, b, h, j + 1, wid, vk0, vk1, vv);
        { const int jp = (j + 3 < NT) ? j + 3 : NT - 1;
          const char* pa = (const char*)PROJ + (size_t)(b * SEQ + 64 * jp) * 512 + (size_t)(wid * 64 + lane) * 128;
          const char* pk = pa + (size_t)(MODE == 0 ? 4 + h : 14 + (h >> 1)) * ((size_t)MTOK * 512);
          const char* pv = pa + (size_t)(MODE == 0 ? 8 + h : 16 + h) * ((size_t)MTOK * 512);
          const char* pp = (wid < 4) ? pk : pv - 32768;
          asm volatile("global_load_dword %0, %1, off" : "=v"(pf_) : "v"(pp) : "memory"); }
        const LAS unsigned char* Kt = cur + comp * 16384; const LAS unsigned char* Vt = cur + V_OFF + vb;
#pragma unroll
        for (int hf = 0; hf < 2; ++hf) {
            const int k0 = 64 * j + 32 * hf;
            if (k0 <= R0 + 31) {
                f32x16 p = f32x16{};
                int kx = (r32 & 7) << 4; asm volatile("" : "+v"(kx));
                const LAS unsigned char* Kr = Kt + (32 * hf + r32) * 256;
#define ATT_KADDR(d0) ((unsigned)(size_t)(Kr + ((((d0) * 16 + hi * 8) * 2) ^ kx)))
#define ATT_QK(d0, kfrag) p = __builtin_amdgcn_mfma_f32_32x32x16_bf16(kfrag, qr[d0], p, 0, 0, 0)
                { bf16x8 ka = lds128(ATT_KADDR(0)), kb = lds128(ATT_KADDR(1)), kc = lds128(ATT_KADDR(2)), kd = lds128(ATT_KADDR(3));
                  ATT_LGKM(2); ATT_SBAR(); ATT_QK(0, ka); ATT_QK(1, kb); ATT_SBAR();
                  ka = lds128(ATT_KADDR(4)); kb = lds128(ATT_KADDR(5));
                  ATT_LGKM(2); ATT_SBAR(); ATT_QK(2, kc); ATT_QK(3, kd); ATT_SBAR();
                  kc = lds128(ATT_KADDR(6)); kd = lds128(ATT_KADDR(7));
                  ATT_LGKM(2); ATT_SBAR(); ATT_QK(4, ka); ATT_QK(5, kb); ATT_SBAR();
                  ATT_LGKM(0); ATT_SBAR(); ATT_QK(6, kc); ATT_QK(7, kd); }
#undef ATT_KADDR
#undef ATT_QK
                const bool diag = k0 + 31 > R0;
                float s2 = slope2; asm volatile("" : "+v"(s2));
                const float tb = s2 * (float)(k0 + 4 * hi - qpos);
                if (MODE == 0) {
                    if (diag) {
#pragma unroll
                        for (int r = 0; r < 16; ++r) if (k0 + crow(r, hi) > qpos) p[r] = NEG;
                    }
                    float pmax = p[0];
#pragma unroll
                    for (int r = 1; r < 16; ++r) pmax = fmaxf(pmax, p[r]);
                    pmax = halfmax(pmax);
                    const float mn = fmaxf(m, pmax), alpha = __builtin_amdgcn_exp2f((m - mn) * C); m = mn;
                    float ps = 0.f;
#pragma unroll
                    for (int r = 0; r < 16; ++r) { p[r] = __builtin_amdgcn_exp2f(fmaf(p[r] - mn, C, fmaf(s2, (float)((r & 3) + 8 * (r >> 2)), tb))); ps += p[r]; }
                    l = l * alpha + ps;
                    if (__any(alpha < 1.0f)) {
                        if (hi == 0) al[r32] = alpha;
                        asm volatile("s_waitcnt lgkmcnt(0)" ::: "memory");
#pragma unroll
                        for (int r = 0; r < 16; ++r) { const float a = al[crow(r, hi)];
#pragma unroll
                            for (int d0 = 0; d0 < 8; ++d0) o[d0][r] *= a; }
                    }
                } else {
#pragma unroll
                    for (int r = 0; r < 16; ++r) p[r] = p[r] * 0.08838834764831845f * __builtin_amdgcn_exp2f(fmaf(s2, (float)((r & 3) + 8 * (r >> 2)), tb));
                    if (diag) {
#pragma unroll
                        for (int r = 0; r < 16; ++r) if (k0 + crow(r, hi) > qpos) p[r] = 0.f;
                    }
                }
                bf16x8 pa0, pa1;
                ATT_PK4(p, 0, pa0); ATT_PK4(p, 8, pa1);
                if (hf == 0) pv_half<0>(o, pa0, pa1, (unsigned)(size_t)Vt); else pv_half<1>(o, pa0, pa1, (unsigned)(size_t)Vt);
            }
        }
        asm volatile("s_waitcnt vmcnt(1)" : "+v"(pf_) :: "memory"); __syncthreads();
    }
    asm volatile("s_waitcnt vmcnt(0)" : "+v"(pf_) :: "memory");
    float sc[16];
    if (MODE == 0) {
        l = halfsum(l);
        float lamv = lam; asm volatile("" : "+v"(lamv));
        if (hi == 0) li[r32] = (comp == 0 ? 1.0f : lamv + 0.2f) / l;
        asm volatile("s_waitcnt lgkmcnt(0)" ::: "memory");
#pragma unroll
        for (int r = 0; r < 16; ++r) sc[r] = li[crow(r, hi)];
        LAS float* EX = (LAS float*)L + (size_t)(w4 * 32) * 256 + r32;
        if (comp == 1) {
#pragma unroll
            for (int r = 0; r < 16; ++r)
#pragma unroll
                for (int d0 = 0; d0 < 8; ++d0) EX[crow(r, hi) * 256 + d0 * 32] = o[d0][r] * sc[r];
        }
        asm volatile("s_waitcnt lgkmcnt(0)" ::: "memory"); __syncthreads();
        if (comp == 0) {
#pragma unroll
            for (int r = 0; r < 16; ++r)
#pragma unroll
                for (int d0 = 0; d0 < 8; ++d0) o[d0][r] = o[d0][r] * sc[r] - EX[crow(r, hi) * 256 + d0 * 32];
        }
    }
    if (MODE == 1 || comp == 0) {
#pragma unroll
        for (int r = 0; r < 16; ++r) { float s = 0.f;
#pragma unroll
            for (int d0 = 0; d0 < 8; ++d0) s += o[d0][r] * o[d0][r];
            s += swz_xor<1>(s); s += swz_xor<2>(s); s += swz_xor<4>(s); s += swz_xor<8>(s); s += swz_xor<16>(s);
            sc[r] = (MODE == 0 ? 0.8f : 1.0f) / sqrtf(s * (1.0f / 256.0f) + NORM_EPS); }
        const size_t orow = (size_t)(b * SEQ + R0);
        LAS unsigned short* st = (LAS unsigned short*)(L + (MODE == 0 ? w4 * 32768 : wid * 16384));
        if (MODE == 0) {
            float g[8];
#pragma unroll
            for (int d0 = 0; d0 < 8; ++d0) g[d0] = subg[d0 * 32 + r32];
#pragma unroll
            for (int r = 0; r < 16; ++r)
#pragma unroll
                for (int d0 = 0; d0 < 8; ++d0) st[crow(r, hi) * 256 + d0 * 32 + r32] = (unsigned short)f2bf(o[d0][r] * sc[r] * g[d0]);
        } else {
            const bf16* Gw = PROJ + (size_t)(20 + h) * ((size_t)MTOK * 256) + orow * 256;
#pragma unroll
            for (int t = 0; t < 16; ++t) { const int idx = t * 64 + lane, row = idx >> 5, c = idx & 31; *(LAS u32x4*)(st + row * 256 + c * 8) = *(const u32x4*)(Gw + (size_t)row * 256 + c * 8); }
            asm volatile("s_waitcnt lgkmcnt(0)" ::: "memory");
#pragma unroll
            for (int r = 0; r < 16; ++r)
#pragma unroll
                for (int d0 = 0; d0 < 8; ++d0) { LAS unsigned short* e = st + crow(r, hi) * 256 + d0 * 32 + r32; const float gt = bf2f(*e);
                    *e = (unsigned short)f2bf(o[d0][r] * sc[r] * (gt * __builtin_amdgcn_rcpf(1.0f + __builtin_amdgcn_exp2f(-LOG2E * gt)))); }
        }
        asm volatile("s_waitcnt lgkmcnt(0)" ::: "memory");
        bf16* Ow = MIX + orow * DM + (MODE == 0 ? 0 : 1024) + h * 256;
#pragma unroll
        for (int t = 0; t < 16; ++t) { const int idx = t * 64 + lane, row = idx >> 5, c = idx & 31; *(u32x4*)(Ow + (size_t)row * DM + c * 8) = *(const LAS u32x4*)(st + row * 256 + c * 8); }
    }
}
__device__ __forceinline__ int p2_class(int k) { const unsigned long long T0 = 0x3d509b2aeb635cfULL, T1 = 0x403110e44994d4ULL; return (int)(((k < 12 ? T0 : T1) >> (5 * (k < 12 ? k : k - 12))) & 31ULL); }
}
#ifndef PROBE_XKV
#define PROBE_XKV 1
#endif
#ifndef PROBE_DACLS
#define PROBE_DACLS -1
#endif
#ifndef PROBE_DA
#define PROBE_DA 1
#endif
#ifndef PROBE_RET
#define PROBE_RET 1
#endif
#ifndef PROBE_P1
#define PROBE_P1 1
#endif
#ifndef PROBE_P3
#define PROBE_P3 1
#endif
#ifndef PROBE_P0
#define PROBE_P0 1
#endif
#ifndef PROBE_P2
#define PROBE_P2 1
#endif
#ifndef PROBE_P4
#define PROBE_P4 1
#endif
#ifndef PROBE_P5
#define PROBE_P5 1
#endif
#ifndef PROBE_P7
#define PROBE_P7 1
#endif
struct Args { const float* in[21]; float* out; unsigned char* ws; };
__global__ void __launch_bounds__(NWAVES * 64, 2) mega_fwd(Args args) {
    extern __shared__ __attribute__((aligned(16))) unsigned char lds[];
    LAS unsigned char* L = (LAS unsigned char*)lds;
    volatile LAS unsigned* MISC = (volatile LAS unsigned*)(L + MISC_OFF);
    const int wave = __builtin_amdgcn_readfirstlane((int)threadIdx.x >> 6);
#define MY_LANE() lane_id_fresh()
    const int G = gridDim.x; const int bx = blockIdx.x; const int vcu = (G % 8 == 0) ? (bx % 8) * (G / 8) + bx / 8 : bx;
    unsigned char* ws = args.ws;
    gu32* ctl = (gu32*)(ws + WS_CTL);
    const float* x = args.in[0]; const float* mem = args.in[1];
    float* out = args.out;
    bf16* Win_t = (bf16*)(ws + WS_WIN); bf16* Wo_t = (bf16*)(ws + WS_WO); bf16* Wxq_t = (bf16*)(ws + WS_WXQ); bf16* Wxkv_t = (bf16*)(ws + WS_WXKV);
    bf16* Wxo_t = (bf16*)(ws + WS_WXO); bf16* Wgu_t = (bf16*)(ws + WS_WGU); bf16* Wd_t = (bf16*)(ws + WS_WD);
    bf16* HM = (bf16*)(ws + WS_HM); bf16* XKV = (bf16*)(ws + WS_XKV); bf16* XB = (bf16*)(ws + WS_B); bf16* MIX = (bf16*)(ws + WS_C);
    bf16* PROJ = (bf16*)(ws + WS_A); bf16* XQ = (bf16*)(ws + WS_A); bf16* XO = (bf16*)(ws + WS_A + 32 * MiB); bf16* HFF = (bf16*)(ws + WS_A);
    float* ssq1 = (float*)(ws + WS_SSQ); float* ssq2 = ssq1 + MTOK; float* ssq3 = ssq2 + MTOK;
    for (int u = (int)threadIdx.x; u < (LDS_BYTES - LDSCTL_OFF) / 4; u += NWAVES * 64) ((LAS unsigned*)(L + LDSCTL_OFF))[u] = 0u;
    __syncthreads();
    XcdBarrier bar = xcd_barrier_post((unsigned*)(ctl + CW_BAR), MISC + 8);
    const int gw = vcu * NWAVES + wave, NGW = G * NWAVES;

    for (int rep_ = 0; rep_ < PROBE_P0; ++rep_) {
        LAS float* scr = (LAS float*)(L + RING_OFF + wave * 16384);
        const int lane = MY_LANE(), tid = wave * 64 + lane;
        constexpr int I_IN = (DM / 64) * (INC / 32), I_SQ = (DM / 64) * (DM / 32), I_FF = (DM / 64) * (DFF / 32), I_DN = (DFF / 64) * (DM / 32);
        constexpr int NITEMS = I_IN + 5 * I_SQ;
        for (int it = gw; it < NITEMS; it += NGW) {
            int r = it;
            if (r < I_IN) { p0_transpose_item(args.in[3], DM, INC, Win_t, 0, 0, nullptr, scr, r, lane); continue; } r -= I_IN;
            if (r < I_SQ) { p0_transpose_item(args.in[9], DM, DM, Wo_t, 0, 0, nullptr, scr, r, lane); continue; } r -= I_SQ;
            if (r < I_SQ) { p0_transpose_item(args.in[12], DM, DM, Wxq_t, 0, 0, args.in[10], scr, r, lane); continue; } r -= I_SQ;
            if (r < I_SQ) { p0_transpose_item(args.in[13], DM, DM, Wxkv_t, 0, 0, nullptr, scr, r, lane); continue; } r -= I_SQ;
            if (r < I_SQ) { p0_transpose_item(args.in[14], DM, DM, Wxkv_t, 0, DM, nullptr, scr, r, lane); continue; } r -= I_SQ;
            p0_transpose_item(args.in[15], DM, DM, Wxo_t, 0, 0, nullptr, scr, r, lane);
        }
        for (int m = gw; m < MTOK; m += NGW) rms_row_to_bf16(x + (size_t)m * DM, args.in[2], XB + (size_t)m * DM, lane);
        for (int m = gw; m < MMEM; m += NGW) rms_row_to_bf16(mem + (size_t)m * DM, args.in[11], HM + (size_t)m * DM, lane);
        for (int i = bx * (NWAVES * 64) + tid; i < 3 * MTOK; i += G * NWAVES * 64) ssq1[i] = 0.f;
    }
    xcd_barrier(bar);

    for (int rep_ = 0; rep_ < PROBE_P1; ++rep_) {
        pg8::Gemm g{XB, Win_t, MTOK, INC, DM}; pg8::StaticOrder S; S.init(MTOK, INC, G, bx);
        pg8::EpiBf16Tiled E{PROJ, MTOK};
        pg8::gemm_phase<pg8::EpiBf16Tiled, pg8::StaticOrder, true, true>(L + RING_OFF, g, S, E, wave);
    }
    xcd_barrier(bar);

    {
        float lam;
        { int l2 = MY_LANE(); asm volatile("" : "+v"(l2));
          const float a1 = args.in[4][l2] * args.in[5][l2] + args.in[4][l2 + 64] * args.in[5][l2 + 64];
          const float a2 = args.in[6][l2] * args.in[7][l2] + args.in[6][l2 + 64] * args.in[7][l2 + 64];
          lam = __uint_as_float(__builtin_amdgcn_readfirstlane(__float_as_uint(__expf(wave_sum(a1)) - __expf(wave_sum(a2))))); }
        const int xg_ = (int)(xb_xcc_id() & 7u);
        for (int rep_ = 0; rep_ < PROBE_P2; ++rep_)
        for (;;) {
#ifdef PROBE_HALF
            if (bx & 8) break;
#endif
            __syncthreads();
            unsigned qa = MISC_OFF; asm volatile("" : "+v"(qa));
            if (wave == 0 && MY_LANE() == 0) *(volatile LAS unsigned*)(L + qa) = __hip_atomic_fetch_add((unsigned*)(ctl + CW_Q + 1024 * rep_ + 64 * xg_), 1u, __ATOMIC_RELAXED, __HIP_MEMORY_SCOPE_AGENT);
            __syncthreads();
            const int q0 = __builtin_amdgcn_readfirstlane((int)*(volatile LAS unsigned*)(L + qa));
            if (q0 >= 8 + 48) break;
            if (q0 < 8) {
                const int u0 = xg_ * 8 + q0;
                pg8::Gemm g{HM, Wxkv_t, MMEM, 2 * DM, DM}; pg8::OneUnit S{u0 & 3, u0 >> 2};
                pg8::EpiBf16 E{XKV, 2 * DM};
                for (int r3_ = 0; r3_ < PROBE_XKV; ++r3_) pg8::gemm_phase<pg8::EpiBf16, pg8::OneUnit, true, true>(L + RING_OFF, g, S, E, wave);
                continue;
            }
            const int u = q0 - 8;
            const int cls = att::p2_class(u >> 1), bh = 2 * xg_ + (u & 1);
            if (cls < 16) { for (int r2_ = 0; r2_ < ((PROBE_DACLS < 0 || cls == PROBE_DACLS) ? PROBE_DA : 1); ++r2_) { att::causal_unit<0>(L, PROJ, MIX, args.in[8], lam, bh >> 2, bh & 3, cls, wave); if (PROBE_DA > 1) __syncthreads(); } }
            else { for (int r2_ = 0; r2_ < PROBE_RET; ++r2_) { att::causal_unit<1>(L, PROJ, MIX, nullptr, 0.f, bh >> 2, bh & 3, cls - 16, wave); if (PROBE_RET > 1) __syncthreads(); } }
        }
    }
    xcd_barrier(bar);

    for (int rep_ = 0; rep_ < PROBE_P3; ++rep_) {
        pg8::Gemm g{MIX, Wo_t, MTOK, DM, DM}; pg8::StaticOrder S; S.init(MTOK, DM, G, bx);
        pg8::EpiResB<true> E{x, nullptr, XB, rep_ == 0 ? ssq1 : ssq1 + 3 * MTOK, DM};
        pg8::gemm_phase<pg8::EpiResB<true>, pg8::StaticOrder, true, true>(L + RING_OFF, g, S, E, wave);
    }
    xcd_barrier(bar);

    for (int rep_ = 0; rep_ < PROBE_P4; ++rep_) {
        pg8::Gemm g{XB, Wxq_t, MTOK, DM, DM}; pg8::StaticOrder S; S.init(MTOK, DM, G, bx);
        pg8::EpiScaleBf16 E{XQ, DM, ssq1};
        pg8::gemm_phase<pg8::EpiScaleBf16, pg8::StaticOrder, true, true>(L + RING_OFF, g, S, E, wave);
    }
    xcd_barrier(bar);

    {
        for (int rep_ = 0; rep_ < PROBE_P5; ++rep_)
        if ((vcu & 1) == 0) { const int u = vcu >> 1, bh = u >> 3; att::xattn_unit(L, XQ, XKV, XO, bh >> 2, bh & 3, u & 7, wave); }
        else {
            LAS float* scr = (LAS float*)(L + RING_OFF + wave * 16384); const int lane = MY_LANE();
            constexpr int I_FF = (DM / 64) * (DFF / 32);
            for (int it = (vcu >> 1) * NWAVES + wave; it < 2 * I_FF; it += (G / 2) * NWAVES) {
                if (it < I_FF) p0_transpose_item(args.in[17], DM, DFF, Wgu_t, 1, 0, args.in[16], scr, it, lane);
                else p0_transpose_item(args.in[18], DM, DFF, Wgu_t, 2, 0, args.in[16], scr, it - I_FF, lane);
            }
        }
    }
    xcd_barrier(bar);

    {
        pg8::Gemm g{XO, Wxo_t, MTOK, DM, DM}; pg8::StaticOrder S; S.init(MTOK, DM, G, bx);
        pg8::EpiResB<false> E{nullptr, XB, XB, ssq2, DM};
        pg8::gemm_phase<pg8::EpiResB<false>, pg8::StaticOrder, true, true>(L + RING_OFF, g, S, E, wave);
    }
    xcd_barrier(bar);

    for (int rep_ = 0; rep_ < PROBE_P7; ++rep_) {
        pg8::Gemm g{XB, Wgu_t, MTOK, 2 * DFF, DM}; pg8::StaticOrder S; S.init(MTOK, 2 * DFF, G, bx);
        pg8::EpiSwiGLU E{HFF, DFF, ssq2};
        pg8::gemm_phase<pg8::EpiSwiGLU, pg8::StaticOrder, true, true>(L + RING_OFF, g, S, E, wave);
        if (rep_ == 0 && bx >= 128) {
            LAS float* scr = (LAS float*)(L + RING_OFF + wave * 16384); const int lane = MY_LANE();
            constexpr int I_DN = (DFF / 64) * (DM / 32);
            for (int it = (bx - 128) * NWAVES + wave; it < I_DN; it += 128 * NWAVES) p0_transpose_item(args.in[19], DFF, DM, Wd_t, 0, 0, nullptr, scr, it, lane);
        }
    }
    xcd_barrier(bar);

    {
        pg8::Gemm g{HFF, Wd_t, MTOK, DM, DFF}; pg8::StaticOrder S; S.init(MTOK, DM, G, bx);
        pg8::EpiResB<false> E{nullptr, XB, XB, ssq3, DM};
        pg8::gemm_phase<pg8::EpiResB<false>, pg8::StaticOrder, true, true>(L + RING_OFF, g, S, E, wave);
    }
    xcd_barrier(bar);

    int lane9 = MY_LANE(); asm volatile("" : "+v"(lane9));
    for (int m = gw; m < MTOK; m += NGW) {
        const float r = 1.0f / sqrtf(ssq3[m] * (1.0f / DM) + NORM_EPS);
        const v4u* xr = (const v4u*)(XB + (size_t)m * DM) + lane9; f32x4* orow = (f32x4*)(out + (size_t)m * DM) + 2 * lane9; const f32x4* gr = (const f32x4*)args.in[20] + 2 * lane9;
#pragma unroll
        for (int j = 0; j < 4; ++j) { const v4u w = xr[64 * j]; const f32x4 g0 = gr[128 * j], g1 = gr[128 * j + 1];
            orow[128 * j] = (f32x4){bflo(w.x), bfhi(w.x), bflo(w.y), bfhi(w.y)} * r * g0; orow[128 * j + 1] = (f32x4){bflo(w.z), bfhi(w.z), bflo(w.w), bfhi(w.w)} * r * g1; }
    }
}

extern "C" void kernel_launch(void* const* d_in, const int* in_sizes, int n_in, void* d_out, int out_size, void* d_ws, size_t ws_size, hipStream_t stream) {
    static int grid = 0;
    if (grid == 0) {
        if (n_in != 21 || in_sizes[0] != MTOK * DM || out_size != MTOK * DM || ws_size < WS_END) { fprintf(stderr, "kernel_launch: unexpected shapes / workspace (n_in %d, ws %zu)\n", n_in, ws_size); grid = -1; return; }
        int dev = 0, cus = 0, per_cu = 0;
        if (hipGetDevice(&dev) != hipSuccess || hipDeviceGetAttribute(&cus, hipDeviceAttributeMultiprocessorCount, dev) != hipSuccess) { grid = -1; return; }
        if (hipFuncSetAttribute((const void*)mega_fwd, hipFuncAttributeMaxDynamicSharedMemorySize, LDS_BYTES) != hipSuccess) { fprintf(stderr, "kernel_launch: hipFuncSetAttribute failed\n"); grid = -1; return; }
        if (hipOccupancyMaxActiveBlocksPerMultiprocessor(&per_cu, (const void*)mega_fwd, NWAVES * 64, LDS_BYTES) != hipSuccess || per_cu < 1) { fprintf(stderr, "kernel_launch: occupancy query reports %d blocks per CU\n", per_cu); (void)hipGetLastError(); grid = -1; return; }
        grid = cus;
    }
    if (grid < 0) return;
    if (hipMemsetAsync((char*)d_ws + WS_CTL, 0, CTL_ZERO_BYTES, stream) != hipSuccess) return;
    Args a{};
    for (int i = 0; i < 21; ++i) a.in[i] = (const float*)d_in[i];
    a.out = (float*)d_out; a.ws = (unsigned char*)d_ws;
    hipLaunchKernelGGL(mega_fwd, dim3(grid), dim3(NWAVES * 64), LDS_BYTES, stream, a);
}
```
